# Optimizing an MI355X kernel written in HIP

```python
import math
import jax
import jax.numpy as jnp
from jax import lax
import numpy as np

D_MODEL = 2048
BATCH = 1
SEQ = 16384
DEPTH = 2

GRID_W = 64
HEAD_DIM = 128
EPS = 1e-6
NEG_INF = -1e30

A_HEADS = 8
A_KV_HEADS = 2
A_WIDTH = A_HEADS * HEAD_DIM
A_KV_WIDTH = A_KV_HEADS * HEAD_DIM
ROPE_THETA = 10000.0
Q_BLOCK = 128
S5_WIDTH = D_MODEL // 2
S5_GROUP = 16
S5_GROUPS = S5_WIDTH // S5_GROUP
S5_STATE = 64
S5_DT_MIN = 0.001
S5_DT_MAX = 0.1
C_HEADS = 8
C_WIDTH = C_HEADS * HEAD_DIM
NA_ROWS = 8
NA_COLS = 16
SSD_WIDTH = D_MODEL // 2
SSD_HEAD_DIM = 64
SSD_HEADS = SSD_WIDTH // SSD_HEAD_DIM
SSD_GROUPS = 2
SSD_STATE = 128
SSD_CONV = 5
SSD_CHUNK = 128
SSD_CONV_CH = SSD_WIDTH + 2 * SSD_GROUPS * SSD_STATE

IN_EVEN = 2 * A_WIDTH + 2 * A_KV_WIDTH + 2 * S5_WIDTH
IN_ODD = 4 * C_WIDTH + SSD_WIDTH + SSD_CONV_CH + 2 * SSD_HEADS
N_EVEN = (DEPTH + 1) // 2
N_ODD = DEPTH // 2

kernel_name = 'hybrid_gqa_s5_natten_ssd_encoder'


def split_cols(t, sizes):
    outs, start = [], 0
    for s in sizes:
        outs.append(t[..., start:start + s])
        start += s
    return outs


def rms_norm(x, g):
    xf = x.astype(jnp.float32)
    y = xf * lax.rsqrt(jnp.mean(xf * xf, axis=-1, keepdims=True) + EPS)
    return (y * g.astype(jnp.float32)).astype(x.dtype)


def ada_modulate(x, c, norm_g, ada_w, ada_b):
    mod = jax.nn.silu(c) @ ada_w + ada_b
    shift, scale, gate = jnp.split(mod, 3, axis=-1)
    h = rms_norm(x, norm_g) * (1.0 + scale[:, None]) + shift[:, None]
    return h, gate[:, None]


def axial_rope_tables(seq_len):
    t = jnp.arange(seq_len)
    row = (t // GRID_W).astype(jnp.float32)
    col = (t % GRID_W).astype(jnp.float32)
    n_axis = HEAD_DIM // 4
    inv = ROPE_THETA ** (-jnp.arange(n_axis, dtype=jnp.float32) / n_axis)
    ang = jnp.concatenate([row[:, None] * inv, col[:, None] * inv], axis=-1)
    return jnp.cos(ang), jnp.sin(ang)


def apply_rope(x, cos, sin):
    xp = x.astype(jnp.float32).reshape(x.shape[:-1] + (HEAD_DIM // 2, 2))
    x1, x2 = xp[..., 0], xp[..., 1]
    cs = cos[None, :, None, :]
    sn = sin[None, :, None, :]
    out = jnp.stack([x1 * cs - x2 * sn, x1 * sn + x2 * cs], axis=-1)
    return out.reshape(x.shape).astype(x.dtype)


def gqa_block_attention(q, k, v):
    bsz, seq, hq, dh = q.shape
    hkv = k.shape[2]
    grp = hq // hkv
    nb = seq // Q_BLOCK
    qb = q.reshape(bsz, nb, Q_BLOCK, hkv, grp, dh).transpose(1, 0, 2, 3, 4, 5)
    scale = dh ** -0.5

    def block(qi):
        s = jnp.einsum('bqkgd,bskd->bkgqs', qi, k).astype(jnp.float32) * scale
        p = jax.nn.softmax(s, axis=-1).astype(v.dtype)
        return jnp.einsum('bkgqs,bskd->bqkgd', p, v)

    o = lax.map(block, qb)
    return o.transpose(1, 0, 2, 3, 4, 5).reshape(bsz, seq, hq * dh)


def _complex_affine_combine(e1, e2):
    a1r, a1i, x1r, x1i = e1
    a2r, a2i, x2r, x2i = e2
    return (a1r * a2r - a1i * a2i,
            a1r * a2i + a1i * a2r,
            a2r * x1r - a2i * x1i + x2r,
            a2r * x1i + a2i * x1r + x2i)


def s5_scan_direction(u, lam_re, lam_im, log_step, b_re, b_im, c_re, c_im, reverse):
    f32 = jnp.float32
    lr = lam_re.astype(f32)
    li = lam_im.astype(f32)
    dt = jnp.exp(log_step.astype(f32))[:, None]
    mag = jnp.exp(lr * dt)
    ab_re = mag * jnp.cos(li * dt)
    ab_im = mag * jnp.sin(li * dt)
    den = lr * lr + li * li
    num_re = ab_re - 1.0
    f_re = (num_re * lr + ab_im * li) / den
    f_im = (ab_im * lr - num_re * li) / den
    br = b_re.astype(f32)
    bi = b_im.astype(f32)
    bb_re = f_re[..., None] * br - f_im[..., None] * bi
    bb_im = f_re[..., None] * bi + f_im[..., None] * br
    x_re = jnp.einsum('gph,blgh->blgp', bb_re, u)
    x_im = jnp.einsum('gph,blgh->blgp', bb_im, u)
    a_re = jnp.broadcast_to(ab_re, x_re.shape)
    a_im = jnp.broadcast_to(ab_im, x_im.shape)
    _, _, h_re, h_im = lax.associative_scan(
        _complex_affine_combine, (a_re, a_im, x_re, x_im), reverse=reverse, axis=1)
    return (jnp.einsum('ghp,blgp->blgh', c_re.astype(f32), h_re)
            - jnp.einsum('ghp,blgp->blgh', c_im.astype(f32), h_im))


def s5_mixer(u, lam_re, lam_im, log_step, b_re, b_im, c_re, c_im, s5_d, w_glu, b_glu):
    bsz, seq, _ = u.shape
    ug = u.astype(jnp.float32).reshape(bsz, seq, S5_GROUPS, S5_GROUP)
    y = s5_d.astype(jnp.float32).reshape(S5_GROUPS, S5_GROUP) * ug
    for direction in range(2):
        y = y + s5_scan_direction(ug, lam_re[direction], lam_im[direction], log_step[direction],
                                  b_re[direction], b_im[direction], c_re[direction],
                                  c_im[direction], reverse=(direction == 1))
    y = jax.nn.gelu(y.reshape(bsz, seq, S5_WIDTH)).astype(u.dtype)
    val, gt = jnp.split(y @ w_glu + b_glu, 2, axis=-1)
    return val * jax.nn.sigmoid(gt)


def neighbourhood_attention(q, k, v, rpb):
    bsz, seq, heads, dh = q.shape
    rows = seq // GRID_W
    kr = min(NA_ROWS, rows)
    qg = q.reshape(bsz, rows, GRID_W, heads, dh)
    kg = k.reshape(bsz, rows, GRID_W, heads, dh)
    vg = v.reshape(bsz, rows, GRID_W, heads, dh)
    col = jnp.arange(GRID_W)
    col_start = jnp.clip(col - NA_COLS // 2, 0, GRID_W - NA_COLS)
    col_mask = (col[None, :] >= col_start[:, None]) & (col[None, :] < col_start[:, None] + NA_COLS)
    dc = jnp.clip(col[None, :] - col[:, None], -(NA_COLS - 1), NA_COLS - 1) + NA_COLS - 1
    rpb_c = rpb[:, :, dc].astype(jnp.float32)
    scale = dh ** -0.5

    def row_block(r):
        rs = jnp.clip(r - NA_ROWS // 2, 0, rows - kr)
        kb = lax.dynamic_slice_in_dim(kg, rs, kr, axis=1)
        vb = lax.dynamic_slice_in_dim(vg, rs, kr, axis=1)
        qr = lax.dynamic_index_in_dim(qg, r, axis=1, keepdims=False)
        s = jnp.einsum('bqhd,brkhd->bhqrk', qr, kb).astype(jnp.float32) * scale
        dr = rs + jnp.arange(kr) - r + NA_ROWS - 1
        bias = jnp.take(rpb_c, dr, axis=1).transpose(0, 2, 1, 3)
        s = jnp.where(col_mask[None, None, :, None, :], s + bias[None], NEG_INF)
        p = jax.nn.softmax(s.reshape(bsz, heads, GRID_W, kr * GRID_W), axis=-1)
        p = p.reshape(bsz, heads, GRID_W, kr, GRID_W).astype(v.dtype)
        return jnp.einsum('bhqrk,brkhd->bqhd', p, vb)

    o = lax.map(row_block, jnp.arange(rows))
    return o.transpose(1, 0, 2, 3, 4).reshape(bsz, seq, heads * dh)


def depthwise_conv_centred(x, w, bias):
    ch = x.shape[-1]
    y = lax.conv_general_dilated(x, w[:, None, :].astype(x.dtype), window_strides=(1,),
                                 padding=[(SSD_CONV // 2, SSD_CONV // 2)],
                                 dimension_numbers=('NWC', 'WIO', 'NWC'),
                                 feature_group_count=ch)
    return y + bias


def segsum(a):
    t = a.shape[-1]
    cs = jnp.cumsum(a, axis=-1)
    diff = cs[..., :, None] - cs[..., None, :]
    return jnp.where(jnp.tril(jnp.ones((t, t), dtype=bool)), diff, -jnp.inf)


def ssd_scan(x, dt, a, bm, cm):
    bsz, seq, heads, hp = x.shape
    n = bm.shape[-1]
    nc = seq // SSD_CHUNK
    xd = (x * dt[..., None]).reshape(bsz, nc, SSD_CHUNK, heads, hp)
    adt = (dt * a).reshape(bsz, nc, SSD_CHUNK, heads).transpose(0, 3, 1, 2)
    bc = bm.reshape(bsz, nc, SSD_CHUNK, heads, n)
    cc = cm.reshape(bsz, nc, SSD_CHUNK, heads, n)
    a_cum = jnp.cumsum(adt, axis=-1)
    scores = jnp.einsum('bclhn,bcshn->bhcls', cc, bc) * jnp.exp(segsum(adt))
    y_diag = jnp.einsum('bhcls,bcshp->bclhp', scores, xd)
    decay_states = jnp.exp(a_cum[..., -1:] - a_cum).transpose(0, 2, 3, 1)
    states = jnp.einsum('bclhn,bclhp->bchpn', bc * decay_states[..., None], xd)
    chunk_tot = jnp.pad(a_cum[..., -1], ((0, 0), (0, 0), (1, 0)))
    decay_chunk = jnp.exp(segsum(chunk_tot))
    states = jnp.concatenate([jnp.zeros_like(states[:, :1]), states], axis=1)
    states = jnp.einsum('bhzc,bchpn->bzhpn', decay_chunk, states)[:, :-1]
    out_decay = jnp.exp(a_cum).transpose(0, 2, 3, 1)
    y_off = jnp.einsum('bclhn,bchpn->bclhp', cc, states) * out_decay[..., None]
    return (y_diag + y_off).reshape(bsz, seq, heads, hp)


def ssd_mixer(z, xbc, dt_raw, conv_w, conv_b, dt_bias, a_log, ssd_d, norm_w):
    f32 = jnp.float32
    bsz, seq, _ = z.shape
    xbc = jax.nn.silu(depthwise_conv_centred(xbc, conv_w, conv_b)).astype(f32)
    xs, bm, cm = split_cols(xbc, (SSD_WIDTH, SSD_GROUPS * SSD_STATE, SSD_GROUPS * SSD_STATE))
    xs = xs.reshape(bsz, seq, SSD_HEADS, SSD_HEAD_DIM)
    rep = SSD_HEADS // SSD_GROUPS
    bm = jnp.repeat(bm.reshape(bsz, seq, SSD_GROUPS, SSD_STATE), rep, axis=2)
    cm = jnp.repeat(cm.reshape(bsz, seq, SSD_GROUPS, SSD_STATE), rep, axis=2)
    dt = jax.nn.softplus(dt_raw.astype(f32).reshape(bsz, seq, 2, SSD_HEADS) + dt_bias.astype(f32))
    a = -jnp.exp(a_log.astype(f32))
    y_fwd = ssd_scan(xs, dt[:, :, 0], a[0], bm, cm)
    flip = lambda t: jnp.flip(t, axis=1)
    y_bwd = flip(ssd_scan(flip(xs), flip(dt[:, :, 1]), a[1], flip(bm), flip(cm)))
    y = y_fwd + y_bwd + ssd_d.astype(f32)[:, None] * xs
    y = y.reshape(bsz, seq, SSD_WIDTH) * jax.nn.silu(z.astype(f32))
    return rms_norm(y, norm_w).astype(z.dtype)


def layer_attn_s5(x, c, norm_g, ada_w, ada_b, w_in, q_norm, k_norm, lam_re, lam_im, log_step,
                  b_re, b_im, c_re, c_im, s5_d, w_glu, b_glu, w_out):
    bsz, seq, _ = x.shape
    h, gate = ada_modulate(x, c, norm_g, ada_w, ada_b)
    q, k, v, g_a, u, g_b = split_cols(
        h @ w_in, (A_WIDTH, A_KV_WIDTH, A_KV_WIDTH, A_WIDTH, S5_WIDTH, S5_WIDTH))
    q = rms_norm(q.reshape(bsz, seq, A_HEADS, HEAD_DIM), q_norm)
    k = rms_norm(k.reshape(bsz, seq, A_KV_HEADS, HEAD_DIM), k_norm)
    cos, sin = axial_rope_tables(seq)
    q = apply_rope(q, cos, sin)
    k = apply_rope(k, cos, sin)
    o_a = gqa_block_attention(q, k, v.reshape(bsz, seq, A_KV_HEADS, HEAD_DIM)) * jax.nn.silu(g_a)
    o_b = s5_mixer(u, lam_re, lam_im, log_step, b_re, b_im, c_re, c_im, s5_d, w_glu, b_glu) * jax.nn.silu(g_b)
    out = jnp.concatenate([o_a, o_b], axis=-1) @ w_out
    return x + gate * out


def layer_na_ssd(x, c, norm_g, ada_w, ada_b, w_in, q_norm, k_norm, rpb, conv_w, conv_b,
                 dt_bias, a_log, ssd_d, norm_w, w_out):
    bsz, seq, _ = x.shape
    h, gate = ada_modulate(x, c, norm_g, ada_w, ada_b)
    q, k, v, g_c, z, xbc, dt_raw = split_cols(
        h @ w_in, (C_WIDTH, C_WIDTH, C_WIDTH, C_WIDTH, SSD_WIDTH, SSD_CONV_CH, 2 * SSD_HEADS))
    q = rms_norm(q.reshape(bsz, seq, C_HEADS, HEAD_DIM), q_norm)
    k = rms_norm(k.reshape(bsz, seq, C_HEADS, HEAD_DIM), k_norm)
    o_c = neighbourhood_attention(q, k, v.reshape(bsz, seq, C_HEADS, HEAD_DIM), rpb) * jax.nn.silu(g_c)
    o_d = ssd_mixer(z, xbc, dt_raw, conv_w, conv_b, dt_bias, a_log, ssd_d, norm_w)
    out = jnp.concatenate([o_c, o_d], axis=-1) @ w_out
    return x + gate * out


def setup_inputs(seed: int = 0) -> dict:
    key = jax.random.key(seed)
    ks = jax.random.split(key, 40)
    f32 = jnp.float32
    D = D_MODEL
    NE, NO = N_EVEN, N_ODD
    G, P, H = S5_GROUPS, S5_STATE, S5_GROUP

    def nrm(i, shape, s):
        return jax.random.normal(ks[i], shape, f32) * s

    n_idx = jnp.arange(P, dtype=f32)
    dt0 = jnp.exp(jax.random.uniform(ks[28], (NO, 2, SSD_HEADS), f32,
                                     minval=math.log(1e-3), maxval=math.log(1e-1)))
    return {
        'x': nrm(0, (BATCH, SEQ, D), 1.0),
        'c': nrm(1, (BATCH, D), 1.0),
        'e_norm_g': 1.0 + nrm(2, (NE, D), 0.02),
        'e_ada_w': nrm(3, (NE, D, 3 * D), D ** -0.5),
        'e_ada_b': nrm(4, (NE, 3 * D), 0.01),
        'e_w_in': nrm(5, (NE, D, IN_EVEN), D ** -0.5),
        'e_q_norm': 1.0 + nrm(6, (NE, HEAD_DIM), 0.02),
        'e_k_norm': 1.0 + nrm(7, (NE, HEAD_DIM), 0.02),
        's5_lam_re': -0.5 + nrm(8, (NE, 2, G, P), 0.01),
        's5_lam_im': math.pi * n_idx + nrm(9, (NE, 2, G, P), 0.01),
        's5_log_step': jax.random.uniform(ks[10], (NE, 2, G), f32,
                                          minval=math.log(S5_DT_MIN), maxval=math.log(S5_DT_MAX)),
        's5_b_re': nrm(11, (NE, 2, G, P, H), (2 * H) ** -0.5),
        's5_b_im': nrm(12, (NE, 2, G, P, H), (2 * H) ** -0.5),
        's5_c_re': nrm(13, (NE, 2, G, H, P), P ** -0.5),
        's5_c_im': nrm(14, (NE, 2, G, H, P), P ** -0.5),
        's5_d': nrm(15, (NE, S5_WIDTH), 1.0),
        's5_w_glu': nrm(16, (NE, S5_WIDTH, 2 * S5_WIDTH), S5_WIDTH ** -0.5),
        's5_b_glu': nrm(17, (NE, 2 * S5_WIDTH), 0.01),
        'e_w_out': nrm(18, (NE, A_WIDTH + S5_WIDTH, D), (A_WIDTH + S5_WIDTH) ** -0.5),
        'o_norm_g': 1.0 + nrm(19, (NO, D), 0.02),
        'o_ada_w': nrm(20, (NO, D, 3 * D), D ** -0.5),
        'o_ada_b': nrm(21, (NO, 3 * D), 0.01),
        'o_w_in': nrm(22, (NO, D, IN_ODD), D ** -0.5),
        'o_q_norm': 1.0 + nrm(23, (NO, HEAD_DIM), 0.02),
        'o_k_norm': 1.0 + nrm(24, (NO, HEAD_DIM), 0.02),
        'na_rpb': nrm(25, (NO, C_HEADS, 2 * NA_ROWS - 1, 2 * NA_COLS - 1), 0.02),
        'ssd_conv_w': nrm(26, (NO, SSD_CONV, SSD_CONV_CH), SSD_CONV ** -0.5),
        'ssd_conv_b': nrm(27, (NO, SSD_CONV_CH), 0.01),
        'ssd_dt_bias': dt0 + jnp.log(-jnp.expm1(-dt0)),
        'ssd_a_log': jnp.log(jax.random.uniform(ks[29], (NO, 2, SSD_HEADS), f32, minval=1.0, maxval=16.0)),
        'ssd_d': 1.0 + nrm(30, (NO, SSD_HEADS), 0.1),
        'ssd_norm_w': 1.0 + nrm(31, (NO, SSD_WIDTH), 0.02),
        'o_w_out': nrm(32, (NO, C_WIDTH + SSD_WIDTH, D), (C_WIDTH + SSD_WIDTH) ** -0.5),
    }


def reference(x, c, e_norm_g, e_ada_w, e_ada_b, e_w_in, e_q_norm, e_k_norm, s5_lam_re, s5_lam_im,
              s5_log_step, s5_b_re, s5_b_im, s5_c_re, s5_c_im, s5_d, s5_w_glu, s5_b_glu, e_w_out,
              o_norm_g, o_ada_w, o_ada_b, o_w_in, o_q_norm, o_k_norm, na_rpb, ssd_conv_w, ssd_conv_b,
              ssd_dt_bias, ssd_a_log, ssd_d, ssd_norm_w, o_w_out):
    for layer in range(DEPTH):
        i = layer // 2
        if layer % 2 == 0:
            x = layer_attn_s5(x, c, e_norm_g[i], e_ada_w[i], e_ada_b[i], e_w_in[i], e_q_norm[i],
                              e_k_norm[i], s5_lam_re[i], s5_lam_im[i], s5_log_step[i], s5_b_re[i],
                              s5_b_im[i], s5_c_re[i], s5_c_im[i], s5_d[i], s5_w_glu[i], s5_b_glu[i],
                              e_w_out[i])
        else:
            x = layer_na_ssd(x, c, o_norm_g[i], o_ada_w[i], o_ada_b[i], o_w_in[i], o_q_norm[i],
                             o_k_norm[i], na_rpb[i], ssd_conv_w[i], ssd_conv_b[i], ssd_dt_bias[i],
                             ssd_a_log[i], ssd_d[i], ssd_norm_w[i], o_w_out[i])
    return x
```

```cpp
#include <hip/hip_runtime.h>
#include <hip/hip_cooperative_groups.h>
#include <cstdio>
#include <cstdint>
namespace cg = cooperative_groups;

typedef unsigned short bf16_t;
using bf16x8 = __attribute__((ext_vector_type(8))) short;
using s16x4  = __attribute__((ext_vector_type(4))) short;
using f32x16 = __attribute__((ext_vector_type(16))) float;
using f32x8  = __attribute__((ext_vector_type(8))) float;
using f32x4  = __attribute__((ext_vector_type(4))) float;
using u32x4  = __attribute__((ext_vector_type(4))) unsigned;
using u32x2  = __attribute__((ext_vector_type(2))) unsigned;

constexpr int L = 16384, DM = 2048, NCH = 128;
constexpr float SCALE = 0.088388347648318440f;
constexpr float THR = 8.f;
constexpr float EPS = 1e-6f;

constexpr size_t SZ_LK  = (size_t)L * 1024 * 2;
constexpr size_t O_WT_IN_E = 0;
constexpr size_t O_WT_GLU  = O_WT_IN_E + (size_t)4608 * 2048 * 2;
constexpr size_t O_WT_IN_O = O_WT_GLU + (size_t)2048 * 1024 * 2;
constexpr size_t O_XBCT    = 0;
constexpr size_t O_WT_OUT_E = O_WT_IN_O + (size_t)6912 * 2048 * 2;
constexpr size_t O_WT_OUT_O = O_WT_OUT_E + (size_t)2048 * 2048 * 2;
constexpr size_t O_MOD  = O_WT_OUT_O + (size_t)2048 * 2048 * 2;
constexpr size_t O_BBAR = O_MOD + 2 * 6144 * 4;
constexpr size_t O_CMAT = O_BBAR + 2 * 64 * 128 * 16 * 2;
constexpr size_t O_AB   = O_CMAT + 2 * 64 * 16 * 128 * 2;
constexpr size_t O_H    = O_AB + 2 * 64 * 64 * 2 * 4;
constexpr size_t O_RA   = O_H + (size_t)L * 2048 * 2;
constexpr size_t O_RB   = O_RA + 4 * SZ_LK;
constexpr size_t O_KR   = O_RB;
constexpr size_t O_KN   = O_KR + (size_t)L * 256 * 2;
constexpr size_t O_V0   = O_KN + (size_t)L * 256 * 2;
constexpr size_t O_S5E  = O_V0 + (size_t)L * 256 * 2;
constexpr size_t O_ZS   = O_RB;
constexpr size_t O_XBCR = O_ZS + SZ_LK;
constexpr size_t O_XBCC = O_XBCR + (size_t)L * 1536 * 2;
constexpr size_t O_DTR  = O_XBCC + (size_t)L * 1536 * 2;
constexpr size_t O_DT   = O_DTR + (size_t)L * 32 * 4;
constexpr size_t O_CUM  = O_DT + (size_t)L * 32 * 4;
constexpr size_t O_TOT  = O_CUM + (size_t)L * 32 * 4;
constexpr size_t O_SSQ  = O_TOT + 128 * 32 * 4;
constexpr size_t O_RB_END = O_SSQ + (size_t)L * 16 * 4;
constexpr size_t O_OA   = O_RB_END;
constexpr size_t O_Y    = O_OA + (size_t)L * 2048 * 2;
constexpr size_t O_BAR  = O_Y + SZ_LK;
constexpr size_t O_SSQ1 = O_BAR + 16384;
constexpr size_t O_SWO  = O_SSQ1 + (size_t)L * 4;
constexpr size_t WS_END = O_SWO + 32768;
static_assert(O_XBCT + (size_t)1536 * L * 2 <= O_WT_OUT_E, "xbcT overlay");
static_assert(O_S5E + (size_t)128 * 64 * 2 * 128 * 4 <= O_RB_END, "layer-0 RB");

struct Params {
  const float *x, *c, *e_norm_g, *e_ada_w, *e_ada_b, *e_w_in, *e_q_norm, *e_k_norm, *s5_lam_re, *s5_lam_im, *s5_log_step, *s5_b_re, *s5_b_im,
              *s5_c_re, *s5_c_im, *s5_d, *s5_w_glu, *s5_b_glu, *e_w_out, *o_norm_g, *o_ada_w, *o_ada_b, *o_w_in, *o_q_norm, *o_k_norm, *na_rpb,
              *ssd_conv_w, *ssd_conv_b, *ssd_dt_bias, *ssd_a_log, *ssd_d, *ssd_norm_w, *o_w_out;
  float* out; unsigned char* ws;
};

#define WAVE_LDS_FENCE() asm volatile("s_waitcnt lgkmcnt(0)" ::: "memory")
__device__ __forceinline__ float bf2f(bf16_t b) { return __uint_as_float(((unsigned)b) << 16); }
__device__ __forceinline__ bf16_t f2bf(float f) { unsigned u = __float_as_uint(f); u += 0x7FFFu + ((u >> 16) & 1u); return (bf16_t)(u >> 16); }
__device__ __forceinline__ unsigned pk2(float lo, float hi) { unsigned r; asm volatile("v_cvt_pk_bf16_f32 %0, %1, %2" : "=v"(r) : "v"(lo), "v"(hi)); return r; }
__device__ __forceinline__ float lo2f(unsigned w) { return __uint_as_float(w << 16); }
__device__ __forceinline__ float hi2f(unsigned w) { return __uint_as_float(w & 0xffff0000u); }
__device__ __forceinline__ float silu_f(float v) { return v * __builtin_amdgcn_rcpf(1.f + __expf(-v)); }
__device__ __forceinline__ float sigmoid_f(float v) { return __builtin_amdgcn_rcpf(1.f + __expf(-v)); }
__device__ __forceinline__ float wave_sum(float v) {
#pragma unroll
  for (int o = 1; o < 64; o <<= 1) v += __shfl_xor(v, o);
  return v;
}
__device__ __forceinline__ void sincos_rev(float ang, float& s, float& c) {
  float rev = ang * 0.15915494309189535f; rev -= floorf(rev);
  s = __builtin_amdgcn_sinf(rev); c = __builtin_amdgcn_cosf(rev);
}
__device__ __forceinline__ f32x4 mfma16(bf16x8 a, bf16x8 b, f32x4 c) { return __builtin_amdgcn_mfma_f32_16x16x32_bf16(a, b, c, 0, 0, 0); }
__device__ __forceinline__ bf16x8 ldfrag(const bf16_t* base, int ld, int r0, int k0, int lane) {
  return *reinterpret_cast<const bf16x8*>(base + (r0 + (lane & 15)) * ld + k0 + (lane >> 4) * 8);
}
namespace pg8 {
#define PG8_LAS __attribute__((address_space(3)))
typedef unsigned short bf16_t;
typedef short bf16x8 __attribute__((ext_vector_type(8)));
typedef float f32x4 __attribute__((ext_vector_type(4)));
typedef unsigned u32x4 __attribute__((ext_vector_type(4)));
constexpr int BM = 256, BK = 64, HALF = 128, HTB = HALF * BK * 2  , STAGE_BYTES = 8 * HTB, NXCD = 8, WGM = 8;

__host__ __device__ __forceinline__ int lds_byte(int r, int c) { const int st = (r >> 4) * 2 + (c >> 5), rr = r & 15, cc = c & 31, ob = rr * 64 + cc * 2; return st * 1024 + (ob ^ (((ob >> 9) & 1) << 5)); }
__host__ __device__ __forceinline__ void stage_rc(int b, int& R, int& C) { const int st = b / 1024, sb = b % 1024, swz = sb ^ (((sb >> 9) & 1) << 5); R = (st >> 1) * 16 + swz / 64; C = (st & 1) * 32 + (swz % 64) / 2; }
__host__ __device__ __forceinline__ int perm32(int rho) { const int n = rho >> 4, i = rho & 15; return 8 * (i >> 2) + 4 * n + (i & 3); }

struct Unit { int pm, pn; };
struct Gemm { const bf16_t* A; const bf16_t* Bt; int M, N, K; };

struct StaticOrder {
    int nM, nN, nwg, G, c;
    __host__ __device__ void init(int M, int N, int G_, int c_) { nM = M / BM; nN = N / BM; nwg = nM * nN; G = G_; c = c_; }
    __host__ __device__ bool next(int i, Unit& u) const {
        const long L = (long)i * G + c; if (L >= nwg) return false;
        int wgid = (int)L; { const int q = nwg / NXCD, r = nwg % NXCD, xcd = wgid % NXCD, off = wgid / NXCD; wgid = (xcd < r ? xcd * (q + 1) : r * (q + 1) + (xcd - r) * q) + off; }
        const int nig = WGM * nN, gid = wgid / nig, fm = gid * WGM, gsz = (nM - fm) < WGM ? (nM - fm) : WGM;
        u.pm = fm + ((wgid % nig) % gsz); u.pn = (wgid % nig) / gsz; return true;
    }
    __device__ __forceinline__ void a_ready(const Unit&) const {}
    __device__ __forceinline__ void done(const Unit&) const {}
};
__device__ __forceinline__ unsigned cvt_pk_bf16(float lo, float hi) { unsigned r; asm volatile("v_cvt_pk_bf16_f32 %0, %1, %2" : "=v"(r) : "v"(lo), "v"(hi)); return r; }
template <class Epi, class Sched, bool ALIGN_EPI = false, bool SP2 = false>
__device__ __forceinline__ void gemm_phase(PG8_LAS unsigned char* lds, const Gemm g, const Sched& S, const Epi& E, const int tid) {
    const int wid = __builtin_amdgcn_readfirstlane(tid >> 6), lane = tid & 63, wr = wid >> 2, wc = wid & 3, fr = lane & 15, fq = lane >> 4;
    const int K = g.K, nt = K / BK;
    unsigned voffA[2], voffB[2];
#pragma unroll
    for (int i = 0; i < 2; ++i) { int R, C; stage_rc(tid * 16 + i * 8192, R, C); const int Rb = Epi::PERM ? ((R & ~31) + perm32(R & 31)) : R;
        voffA[i] = (unsigned)(R * K + C) * 2u; voffB[i] = (unsigned)(Rb * K + C) * 2u; }
    const size_t kstep = (size_t)(BK * 2);
    const size_t hstep = (size_t)HALF * K * 2;
    const size_t tstep = 2 * hstep;
    const unsigned ldsw = (unsigned)wid * 1024u;
    const int aoff = lds_byte(wr * 64 + fr, fq * 8), boff = lds_byte(wc * 32 + fr, fq * 8);
#define PG8_SA(b, h) (((b) * 2 + (h)) * HTB)
#define PG8_SB(b, h) ((4 + (b) * 2 + (h)) * HTB)
#define PG8_STAGE(bufoff, gbase, voff) do { _Pragma("unroll") for (int _i = 0; _i < 2; ++_i) \
        __builtin_amdgcn_global_load_lds((const unsigned*)((const char*)(gbase) + (voff)[_i]), (PG8_LAS unsigned*)(lds + (bufoff) + ldsw + _i * 8192), 16, 0, 0); } while (0)
#define PG8_LDA(dst, b, h) do { _Pragma("unroll") for (int m = 0; m < 4; ++m) _Pragma("unroll") for (int k = 0; k < 2; ++k) dst[m][k] = *(const PG8_LAS bf16x8*)(lds + PG8_SA(b, h) + aoff + m * 2048 + k * 1024); } while (0)
#define PG8_LDB(dst, b, h) do { _Pragma("unroll") for (int n = 0; n < 2; ++n) _Pragma("unroll") for (int k = 0; k < 2; ++k) dst[n][k] = *(const PG8_LAS bf16x8*)(lds + PG8_SB(b, h) + boff + n * 2048 + k * 1024); } while (0)
#define PG8_MMA(ai, bj, At, Bt) do { __builtin_amdgcn_s_setprio(1); _Pragma("unroll") for (int m = 0; m < 4; ++m) _Pragma("unroll") for (int n = 0; n < 2; ++n) _Pragma("unroll") for (int k = 0; k < 2; ++k) \
        acc[ai][bj][m][n] = __builtin_amdgcn_mfma_f32_16x16x32_bf16(Bt[n][k], At[m][k], acc[ai][bj][m][n], 0, 0, 0); __builtin_amdgcn_s_setprio(0); } while (0)
#define PG8_WAIT_V(n) asm volatile("s_waitcnt vmcnt(" #n ")" ::: "memory")
#define PG8_WAIT_L(n) asm volatile("s_waitcnt lgkmcnt(" #n ")" ::: "memory")
#define PG8_BAR __builtin_amdgcn_s_barrier()
#define PG8_SCHED __builtin_amdgcn_sched_barrier(0)
    Unit cur, nxt; int ui = 0;
    if (!S.next(0, cur)) return;
    f32x4 acc[2][2][4][2];
#pragma unroll
    for (int a = 0; a < 2; ++a)
#pragma unroll
        for (int b = 0; b < 2; ++b)
#pragma unroll
            for (int m = 0; m < 4; ++m)
#pragma unroll
                for (int n = 0; n < 2; ++n) acc[a][b][m][n] = (f32x4){0.f, 0.f, 0.f, 0.f};
    bf16x8 At[4][2], B0[2][2], B1[2][2];
    const char* cA = (const char*)g.A + (size_t)cur.pm * tstep; const char* cB = (const char*)g.Bt + (size_t)cur.pn * tstep;
    S.a_ready(cur);
    if constexpr (SP2) {
        PG8_STAGE(PG8_SB(0, 0), cB, voffB); PG8_STAGE(PG8_SB(0, 1), cB + hstep, voffB); PG8_STAGE(PG8_SA(0, 0), cA, voffA); PG8_STAGE(PG8_SA(0, 1), cA + hstep, voffA);
        if (wr == 1) PG8_BAR;
        PG8_WAIT_V(2); PG8_BAR;
        PG8_STAGE(PG8_SB(1, 0), cB + kstep, voffB); PG8_STAGE(PG8_SA(1, 0), cA + kstep, voffA); PG8_STAGE(PG8_SB(1, 1), cB + hstep + kstep, voffB);
        PG8_WAIT_V(6); PG8_BAR;
    } else {
        PG8_STAGE(PG8_SB(0, 0), cB, voffB); PG8_STAGE(PG8_SA(0, 0), cA, voffA); PG8_STAGE(PG8_SB(0, 1), cB + hstep, voffB); PG8_STAGE(PG8_SA(0, 1), cA + hstep, voffA);
        if (wr == 1) PG8_BAR;
        PG8_WAIT_V(4); PG8_BAR;
        PG8_STAGE(PG8_SB(1, 0), cB + kstep, voffB); PG8_STAGE(PG8_SA(1, 0), cA + kstep, voffA); PG8_STAGE(PG8_SB(1, 1), cB + hstep + kstep, voffB);
        PG8_WAIT_V(6); PG8_BAR;
    }
    for (;;) {
        const bool has_next = S.next(ui + 1, nxt);
        const char* nA = has_next ? (const char*)g.A + (size_t)nxt.pm * tstep : cA; const char* nB = has_next ? (const char*)g.Bt + (size_t)nxt.pn * tstep : cB;
        for (int t = 0; t < nt; t += 2) {
            const bool last = (t == nt - 2);
            const char* a1 = cA + (size_t)(t + 1) * kstep;
            const char* a2 = last ? nA : cA + (size_t)(t + 2) * kstep; const char* b2 = last ? nB : cB + (size_t)(t + 2) * kstep;
            const char* a3 = a2 + kstep; const char* b3 = b2 + kstep;
            if (last && has_next) S.a_ready(nxt);
            if constexpr (Epi::MIDSCALE) { if (t == nt / 2) E.midscale(acc, cur, wr, fr); }
            if constexpr (SP2) {
            PG8_LDB(B0, 0, 0); PG8_LDB(B1, 0, 1); PG8_SCHED; PG8_LDA(At, 0, 0); PG8_STAGE(PG8_SA(1, 1), a1 + hstep, voffA);
            PG8_WAIT_V(8); PG8_WAIT_L(0); PG8_BAR; PG8_MMA(0, 0, At, B0); PG8_MMA(0, 1, At, B1); PG8_BAR; PG8_SCHED;
            PG8_LDA(At, 0, 1); PG8_STAGE(PG8_SB(0, 0), b2, voffB); PG8_STAGE(PG8_SB(0, 1), b2 + hstep, voffB); PG8_STAGE(PG8_SA(0, 0), a2, voffA);
            PG8_WAIT_V(8); PG8_WAIT_L(0); PG8_BAR; PG8_MMA(1, 0, At, B0); PG8_MMA(1, 1, At, B1); PG8_BAR; PG8_SCHED;
            PG8_LDB(B0, 1, 0); PG8_LDB(B1, 1, 1); PG8_SCHED; PG8_LDA(At, 1, 0); PG8_STAGE(PG8_SA(0, 1), a2 + hstep, voffA);
            PG8_WAIT_V(8); PG8_WAIT_L(0); PG8_BAR; PG8_MMA(0, 0, At, B0); PG8_MMA(0, 1, At, B1); PG8_BAR; PG8_SCHED;
            PG8_LDA(At, 1, 1); PG8_STAGE(PG8_SB(1, 0), b3, voffB); PG8_STAGE(PG8_SB(1, 1), b3 + hstep, voffB); PG8_STAGE(PG8_SA(1, 0), a3, voffA);
            PG8_WAIT_V(8); PG8_WAIT_L(0); PG8_BAR; PG8_MMA(1, 0, At, B0); PG8_MMA(1, 1, At, B1); PG8_BAR; PG8_SCHED;
            } else {
            PG8_LDB(B0, 0, 0); PG8_SCHED; PG8_LDA(At, 0, 0); PG8_STAGE(PG8_SA(1, 1), a1 + hstep, voffA);
            PG8_WAIT_L(8); PG8_BAR; PG8_WAIT_L(0); PG8_MMA(0, 0, At, B0); PG8_BAR; PG8_SCHED;
            PG8_LDB(B1, 0, 1); PG8_STAGE(PG8_SB(0, 0), b2, voffB);
            PG8_BAR; PG8_WAIT_L(0); PG8_MMA(0, 1, At, B1); PG8_BAR;
            PG8_LDA(At, 0, 1); PG8_STAGE(PG8_SA(0, 0), a2, voffA);
            PG8_BAR; PG8_WAIT_L(0); PG8_MMA(1, 0, At, B0); PG8_BAR; PG8_SCHED;
            PG8_STAGE(PG8_SB(0, 1), b2 + hstep, voffB);
            PG8_WAIT_V(6); PG8_BAR; PG8_MMA(1, 1, At, B1); PG8_BAR;
            PG8_LDB(B0, 1, 0); PG8_SCHED; PG8_LDA(At, 1, 0); PG8_STAGE(PG8_SA(0, 1), a2 + hstep, voffA);
            PG8_WAIT_L(8); PG8_BAR; PG8_WAIT_L(0); PG8_MMA(0, 0, At, B0); PG8_BAR; PG8_SCHED;
            PG8_LDB(B1, 1, 1); PG8_STAGE(PG8_SB(1, 0), b3, voffB);
            PG8_BAR; PG8_WAIT_L(0); PG8_MMA(0, 1, At, B1); PG8_BAR;
            PG8_LDA(At, 1, 1); PG8_STAGE(PG8_SA(1, 0), a3, voffA);
            PG8_BAR; PG8_WAIT_L(0); PG8_MMA(1, 0, At, B0); PG8_BAR; PG8_SCHED;
            PG8_STAGE(PG8_SB(1, 1), b3 + hstep, voffB);
            PG8_WAIT_V(6); PG8_BAR; PG8_MMA(1, 1, At, B1); PG8_BAR;
            }
        }
        if constexpr (ALIGN_EPI) { if (wr == 0) PG8_BAR; }
        if constexpr (!Epi::AFTER_DRAIN) { E(acc, cur, wr, wc, fr, fq); S.done(cur); }
        if (!has_next) break;
#pragma unroll
        for (int a = 0; a < 2; ++a)
#pragma unroll
            for (int b = 0; b < 2; ++b)
#pragma unroll
                for (int m = 0; m < 4; ++m)
#pragma unroll
                    for (int n = 0; n < 2; ++n) acc[a][b][m][n] = (f32x4){0.f, 0.f, 0.f, 0.f};
        cur = nxt; cA = nA; cB = nB; ++ui;
        if constexpr (ALIGN_EPI) { if (wr == 1) PG8_BAR; }
    }
    PG8_WAIT_V(0);
    if constexpr (!ALIGN_EPI) { if (wr == 0) PG8_BAR; }
    PG8_BAR;
    if constexpr (Epi::AFTER_DRAIN) { E.fused(acc, cur, wr, wc, fr, fq, lds, wid, lane); S.done(cur); }
#undef PG8_SA
#undef PG8_SB
#undef PG8_STAGE
#undef PG8_LDA
#undef PG8_LDB
#undef PG8_MMA
#undef PG8_WAIT_V
#undef PG8_WAIT_L
#undef PG8_BAR
#undef PG8_SCHED
}
}
namespace pg8 {
struct EpiSplit {
  static constexpr bool PERM = true, AFTER_DRAIN = false, MIDSCALE = false;
  unsigned char* ws; int layer;
  __device__ __forceinline__ void operator()(const f32x4 (&acc)[2][2][4][2], const Unit& u, int wr, int wc, int fr_, int fq_) const {
    int fr = fr_, fq = fq_; asm volatile("" : "+v"(fr), "+v"(fq));
    unsigned char* ws = this->ws; asm volatile("" : "+s"(ws));
    float rs[2][4]; f32x4 sw[2][2];
#pragma unroll
    for (int ai = 0; ai < 2; ++ai)
#pragma unroll
      for (int m = 0; m < 4; ++m) rs[ai][m] = 1.f;
#pragma unroll
    for (int bj = 0; bj < 2; ++bj)
#pragma unroll
      for (int n = 0; n < 2; ++n) sw[bj][n] = (f32x4){0.f, 0.f, 0.f, 0.f};
    if (layer == 1) { const float* sq = (const float*)(ws + O_SSQ1); const float* sWp = (const float*)(ws + O_SWO);
#pragma unroll
      for (int ai = 0; ai < 2; ++ai)
#pragma unroll
        for (int m = 0; m < 4; ++m) rs[ai][m] = rsqrtf(sq[u.pm * BM + ai * HALF + wr * 64 + m * 16 + fr] * (1.f / DM) + EPS);
#pragma unroll
      for (int bj = 0; bj < 2; ++bj)
#pragma unroll
        for (int n = 0; n < 2; ++n) sw[bj][n] = *(const f32x4*)(sWp + u.pn * BM + bj * HALF + wc * 32 + 8 * fq + 4 * n); }
    bf16_t* dst; int ld, c0, act = 0; const int pn = u.pn;
    if (layer == 0) {
      if (pn < 4)       { dst = (bf16_t*)(ws + O_RA);             ld = 1024; c0 = pn * 256; }
      else if (pn == 4) { dst = (bf16_t*)(ws + O_KR);             ld = 256;  c0 = 0; }
      else if (pn == 5) { dst = (bf16_t*)(ws + O_V0);             ld = 256;  c0 = 0; }
      else if (pn < 10) { dst = (bf16_t*)(ws + O_RA + SZ_LK);     ld = 1024; c0 = (pn - 6) * 256; act = 1; }
      else if (pn < 14) { dst = (bf16_t*)(ws + O_RA + 2 * SZ_LK); ld = 1024; c0 = (pn - 10) * 256; }
      else              { dst = (bf16_t*)(ws + O_RA + 3 * SZ_LK); ld = 1024; c0 = (pn - 14) * 256; act = 1; }
    } else {
      if (pn < 12)      { dst = (bf16_t*)(ws + O_RA + (size_t)(pn >> 2) * SZ_LK); ld = 1024; c0 = (pn & 3) * 256; }
      else if (pn < 16) { dst = (bf16_t*)(ws + O_RA + 3 * SZ_LK); ld = 1024; c0 = (pn - 12) * 256; act = 1; }
      else if (pn < 20) { dst = (bf16_t*)(ws + O_ZS);             ld = 1024; c0 = (pn - 16) * 256; act = 1; }
      else if (pn < 26) { dst = (bf16_t*)(ws + O_XBCR);           ld = 1536; c0 = (pn - 20) * 256; }
      else {
        if (wc == 0) {
          float* d = (float*)(ws + O_DTR);
#pragma unroll
          for (int ai = 0; ai < 2; ++ai)
#pragma unroll
            for (int m = 0; m < 4; ++m) { const int row = u.pm * BM + ai * HALF + wr * 64 + m * 16 + fr;
              *(f32x4*)(d + (size_t)row * 32 + 8 * fq)     = acc[ai][0][m][0] * rs[ai][m] + sw[0][0];
              *(f32x4*)(d + (size_t)row * 32 + 8 * fq + 4) = acc[ai][0][m][1] * rs[ai][m] + sw[0][1]; }
        }
        return;
      }
    }
    const int row0 = u.pm * BM + wr * 64 + fr, col0 = c0 + wc * 32 + 8 * fq;
#pragma unroll
    for (int ai = 0; ai < 2; ++ai)
#pragma unroll
      for (int m = 0; m < 4; ++m) { bf16_t* rowp = dst + (size_t)(row0 + ai * HALF + m * 16) * ld + col0;
#pragma unroll
        for (int bj = 0; bj < 2; ++bj) { f32x4 v0 = acc[ai][bj][m][0] * rs[ai][m] + sw[bj][0], v1 = acc[ai][bj][m][1] * rs[ai][m] + sw[bj][1];
          if (act) {
#pragma unroll
            for (int e = 0; e < 4; ++e) { v0[e] = silu_f(v0[e]); v1[e] = silu_f(v1[e]); } }
          u32x4 o; o[0] = pk2(v0[0], v0[1]); o[1] = pk2(v0[2], v0[3]); o[2] = pk2(v1[0], v1[1]); o[3] = pk2(v1[2], v1[3]);
          *(u32x4*)(rowp + bj * HALF) = o; } }
  }
};
struct EpiGlu {
  static constexpr bool PERM = true, AFTER_DRAIN = false, MIDSCALE = false;
  unsigned char* ws; const float* bias;
  __device__ __forceinline__ void operator()(const f32x4 (&acc)[2][2][4][2], const Unit& u, int wr, int wc, int fr_, int fq_) const {
    int fr = fr_, fq = fq_; asm volatile("" : "+v"(fr), "+v"(fq));
    unsigned char* ws = this->ws; const float* bias = this->bias; asm volatile("" : "+s"(ws), "+s"(bias));
    const bf16_t* gb = (const bf16_t*)(ws + O_RA + 3 * SZ_LK); bf16_t* oa = (bf16_t*)(ws + O_OA);
    const int row0 = u.pm * BM + wr * 64 + fr, col = u.pn * 128 + wc * 32 + 8 * fq;
    const f32x4 bv0 = *(const f32x4*)(bias + col), bv1 = *(const f32x4*)(bias + col + 4), bg0 = *(const f32x4*)(bias + 1024 + col), bg1 = *(const f32x4*)(bias + 1024 + col + 4);
#pragma unroll
    for (int ai = 0; ai < 2; ++ai)
#pragma unroll
      for (int m = 0; m < 4; ++m) { const size_t row = (size_t)(row0 + ai * HALF + m * 16);
        const u32x4 g = *(const u32x4*)(gb + row * 1024 + col);
        f32x4 a0 = acc[ai][0][m][0] + bv0, a1 = acc[ai][0][m][1] + bv1, t0 = acc[ai][1][m][0] + bg0, t1 = acc[ai][1][m][1] + bg1;
        float r[8];
#pragma unroll
        for (int e = 0; e < 4; ++e) { r[e] = a0[e] * sigmoid_f(t0[e]); r[4 + e] = a1[e] * sigmoid_f(t1[e]); }
        u32x4 o;
#pragma unroll
        for (int e = 0; e < 4; ++e) o[e] = pk2(r[2 * e] * lo2f(g[e]), r[2 * e + 1] * hi2f(g[e]));
        *(u32x4*)(oa + row * 2048 + 1024 + col) = o; }
  }
};
struct EpiRes {
  static constexpr bool PERM = false, AFTER_DRAIN = false, MIDSCALE = false;
  const float* xres; float* out; const float* gate;
  __device__ __forceinline__ void operator()(const f32x4 (&acc)[2][2][4][2], const Unit& u, int wr, int wc, int fr_, int fq_) const {
    int fr = fr_, fq = fq_; asm volatile("" : "+v"(fr), "+v"(fq));
    const float* xres = this->xres; float* out = this->out; const float* gate = this->gate; asm volatile("" : "+s"(xres), "+s"(out), "+s"(gate));
    const int row0 = u.pm * BM + wr * 64 + fr, col0 = u.pn * BM + wc * 32 + 4 * fq;
    f32x4 gv[2][2];
#pragma unroll
    for (int bj = 0; bj < 2; ++bj)
#pragma unroll
      for (int n = 0; n < 2; ++n) gv[bj][n] = *(const f32x4*)(gate + col0 + bj * HALF + n * 16);
#pragma unroll
    for (int ai = 0; ai < 2; ++ai)
#pragma unroll
      for (int m = 0; m < 4; ++m) { const size_t off = (size_t)(row0 + ai * HALF + m * 16) * DM + col0;
#pragma unroll
        for (int bj = 0; bj < 2; ++bj)
#pragma unroll
          for (int n = 0; n < 2; ++n) { const f32x4 xr = *(const f32x4*)(xres + off + bj * HALF + n * 16);
            *(f32x4*)(out + off + bj * HALF + n * 16) = xr + gv[bj][n] * acc[ai][bj][m][n]; } }
  }
};
struct EpiResX {
  static constexpr bool PERM = false, AFTER_DRAIN = false, MIDSCALE = false;
  const float* xres; float* out; const float* gate; bf16_t* xb; float* ssq1;
  __device__ __forceinline__ void operator()(const f32x4 (&acc)[2][2][4][2], const Unit& u, int wr, int wc, int fr_, int fq_) const {
    int fr = fr_, fq = fq_; asm volatile("" : "+v"(fr), "+v"(fq));
    const float* xres = this->xres; float* out = this->out; const float* gate = this->gate; asm volatile("" : "+s"(xres), "+s"(out), "+s"(gate));
    bf16_t* xbp = this->xb; float* sqp = this->ssq1; asm volatile("" : "+s"(xbp), "+s"(sqp));
    const int row0 = u.pm * BM + wr * 64 + fr, col0 = u.pn * BM + wc * 32 + 4 * fq;
    f32x4 gv[2][2];
#pragma unroll
    for (int bj = 0; bj < 2; ++bj)
#pragma unroll
      for (int n = 0; n < 2; ++n) gv[bj][n] = *(const f32x4*)(gate + col0 + bj * HALF + n * 16);
#pragma unroll
    for (int ai = 0; ai < 2; ++ai)
#pragma unroll
      for (int m = 0; m < 4; ++m) { const size_t off = (size_t)(row0 + ai * HALF + m * 16) * DM + col0; float s = 0.f;
#pragma unroll
        for (int bj = 0; bj < 2; ++bj)
#pragma unroll
          for (int n = 0; n < 2; ++n) { const f32x4 xr = *(const f32x4*)(xres + off + bj * HALF + n * 16);
            const f32x4 v = xr + gv[bj][n] * acc[ai][bj][m][n];
            *(f32x4*)(out + off + bj * HALF + n * 16) = v;
            u32x2 w = {pk2(v[0], v[1]), pk2(v[2], v[3])}; *(u32x2*)(xbp + off + bj * HALF + n * 16) = w;
            s += v[0] * v[0] + v[1] * v[1] + v[2] * v[2] + v[3] * v[3]; }
        s += __shfl_xor(s, 16); s += __shfl_xor(s, 32);
        if (fq == 0) atomicAdd(sqp + row0 + ai * HALF + m * 16, s); }
  }
};
struct EpiResScale {
  static constexpr bool PERM = false, AFTER_DRAIN = false, MIDSCALE = true;
  const float* xres; float* out; const float* gate; const float* ssq;
  __device__ __forceinline__ void midscale(f32x4 (&acc)[2][2][4][2], const Unit& u, int wr, int fr_) const {
    int fr = fr_; asm volatile("" : "+v"(fr)); const float* sq = this->ssq; asm volatile("" : "+s"(sq));
#pragma unroll
    for (int ai = 0; ai < 2; ++ai)
#pragma unroll
      for (int m = 0; m < 4; ++m) { const int row = u.pm * BM + ai * HALF + wr * 64 + m * 16 + fr;
        const float s0 = sq[(size_t)row * 2], s1 = sq[(size_t)row * 2 + 1]; const float rstd = rsqrtf((s0 + s1) * (1.f / 1024.f) + EPS);
#pragma unroll
        for (int bj = 0; bj < 2; ++bj)
#pragma unroll
          for (int n = 0; n < 2; ++n) acc[ai][bj][m][n] *= rstd; }
  }
  __device__ __forceinline__ void operator()(const f32x4 (&acc)[2][2][4][2], const Unit& u, int wr, int wc, int fr_, int fq_) const {
    int fr = fr_, fq = fq_; asm volatile("" : "+v"(fr), "+v"(fq));
    const float* xres = this->xres; float* out = this->out; const float* gate = this->gate; asm volatile("" : "+s"(xres), "+s"(out), "+s"(gate));
    const int row0 = u.pm * BM + wr * 64 + fr, col0 = u.pn * BM + wc * 32 + 4 * fq;
    f32x4 gv[2][2];
#pragma unroll
    for (int bj = 0; bj < 2; ++bj)
#pragma unroll
      for (int n = 0; n < 2; ++n) gv[bj][n] = *(const f32x4*)(gate + col0 + bj * HALF + n * 16);
#pragma unroll
    for (int ai = 0; ai < 2; ++ai)
#pragma unroll
      for (int m = 0; m < 4; ++m) { const size_t off = (size_t)(row0 + ai * HALF + m * 16) * DM + col0;
#pragma unroll
        for (int bj = 0; bj < 2; ++bj)
#pragma unroll
          for (int n = 0; n < 2; ++n) { const f32x4 xr = *(const f32x4*)(xres + off + bj * HALF + n * 16);
            *(f32x4*)(out + off + bj * HALF + n * 16) = xr + gv[bj][n] * acc[ai][bj][m][n]; } }
  }
};
}
using bf16 = bf16_t;
#define KSWZ(row, colB) ((row) * 256 + ((colB) ^ (((row) & 7) << 4)))
#define SBAR() __builtin_amdgcn_sched_barrier(0)
__device__ __forceinline__ int crow(int r, int hi) { return (r & 3) + 8 * (r >> 2) + 4 * hi; }
__device__ __forceinline__ unsigned cvtpk(float lo, float hi) {
  unsigned r; asm volatile("v_cvt_pk_bf16_f32 %0, %1, %2" : "=v"(r) : "v"(lo), "v"(hi)); return r;
}
__device__ __forceinline__ void partialSM(f32x16& p0, f32x16& p1, float& m_reg, float& mn, float& alpha) {
  constexpr float C = SCALE * 1.4426950408889634f;
  float pmax = p0[0]; for (int r = 1; r < 16; ++r) pmax = fmaxf(pmax, p0[r]); for (int r = 0; r < 16; ++r) pmax = fmaxf(pmax, p1[r]);
  { auto rr = __builtin_amdgcn_permlane32_swap(__float_as_uint(pmax), __float_as_uint(pmax), false, false);
    pmax = fmaxf(__uint_as_float(rr[0]), __uint_as_float(rr[1])); }
  if (__builtin_expect(__all(pmax - m_reg <= THR / SCALE), 1)) { mn = m_reg; alpha = 1.f; }
  else { mn = fmaxf(m_reg, pmax); alpha = __builtin_amdgcn_exp2f((m_reg - mn) * C); m_reg = mn; }
  float mnC = -mn * C;
  for (int r = 0; r < 16; ++r) p0[r] = fmaf(p0[r], C, mnC); for (int r = 0; r < 16; ++r) p1[r] = fmaf(p1[r], C, mnC);
  for (int r = 0; r < 16; ++r) p0[r] = __builtin_amdgcn_exp2f(p0[r]);
}
__device__ __forceinline__ void finishSM(f32x16& p0, f32x16& p1, float alpha, float& l_reg, bf16x8& pa0, bf16x8& pa1, bf16x8& pa2, bf16x8& pa3) {
  for (int r = 0; r < 16; ++r) p1[r] = __builtin_amdgcn_exp2f(p1[r]);
  float ps = 0; for (int r = 0; r < 16; ++r) ps += p0[r]; for (int r = 0; r < 16; ++r) ps += p1[r];
  { auto rr = __builtin_amdgcn_permlane32_swap(__float_as_uint(ps), __float_as_uint(ps), false, false);
    ps = __uint_as_float(rr[0]) + __uint_as_float(rr[1]); }
  l_reg = l_reg * alpha + ps;
#define PK4(P, BASE, OUT) do { unsigned a0 = cvtpk(P[BASE + 0], P[BASE + 1]), a1 = cvtpk(P[BASE + 2], P[BASE + 3]);   \
    unsigned b0 = cvtpk(P[BASE + 4], P[BASE + 5]), b1 = cvtpk(P[BASE + 6], P[BASE + 7]);                              \
    auto r0 = __builtin_amdgcn_permlane32_swap(a0, b0, false, false); auto r1 = __builtin_amdgcn_permlane32_swap(a1, b1, false, false); \
    u32x4 w = {r0[0], r1[0], r0[1], r1[1]}; OUT = *reinterpret_cast<bf16x8*>(&w); } while (0)
  PK4(p0, 0, pa0); PK4(p0, 8, pa1); PK4(p1, 0, pa2); PK4(p1, 8, pa3);
#undef PK4
}
template <bool ZERO, bool QLDS> __device__ __forceinline__ void qkt(f32x16& p0, f32x16& p1, const bf16* Ks, const bf16x8* qr, int r32, int hi, const char* qrow) {
  if (ZERO) { p0 = f32x16{}; p1 = f32x16{}; }
  for (int d0 = 0; d0 < 8; ++d0) { int cb = (d0 * 16 + hi * 8) * 2;
    bf16x8 b0 = *reinterpret_cast<const bf16x8*>((const char*)Ks + KSWZ(r32, cb));
    bf16x8 b1 = *reinterpret_cast<const bf16x8*>((const char*)Ks + KSWZ(32 + r32, cb));
    bf16x8 q; if (QLDS) q = *reinterpret_cast<const bf16x8*>(qrow + (cb ^ ((r32 & 7) << 4))); else q = qr[d0];
    p0 = __builtin_amdgcn_mfma_f32_32x32x16_bf16(b0, q, p0, 0, 0, 0);
    p1 = __builtin_amdgcn_mfma_f32_32x32x16_bf16(b1, q, p1, 0, 0, 0); }
}
__device__ __forceinline__ int v_st(int k, int c) { const int kk = (k & ~0xC) | ((k & 4) << 1) | ((k & 8) >> 1); return ((kk >> 3) * 4 + (c >> 5)) * 512 + ((kk & 7) * 32 + (c & 31)) * 2; }
__device__ __forceinline__ int v_rd_base(int lane) { return ((lane & 3) << 3) | (((lane >> 2) & 3) << 6) | (((lane >> 4) & 1) << 5) | (((lane >> 5) & 1) << 8); }
constexpr int v_rd_off(int d0, int ks, int half) { return d0 * 512 + ks * 4096 + half * 2048; }
template <int OFF> __device__ __forceinline__ s16x4 tr_read(int vb) {
  s16x4 r; asm volatile("ds_read_b64_tr_b16 %0, %1 offset:%2" : "=&v"(r) : "v"(vb), "i"(OFF) : "memory"); return r;
}
template <int D0> __device__ __forceinline__ void pv_one(f32x16& od, int vb, bf16x8 pa0, bf16x8 pa1, bf16x8 pa2, bf16x8 pa3) {
  const s16x4 l0 = tr_read<v_rd_off(D0, 0, 0)>(vb), h0 = tr_read<v_rd_off(D0, 0, 1)>(vb), l1 = tr_read<v_rd_off(D0, 1, 0)>(vb), h1 = tr_read<v_rd_off(D0, 1, 1)>(vb);
  const s16x4 l2 = tr_read<v_rd_off(D0, 2, 0)>(vb), h2 = tr_read<v_rd_off(D0, 2, 1)>(vb), l3 = tr_read<v_rd_off(D0, 3, 0)>(vb), h3 = tr_read<v_rd_off(D0, 3, 1)>(vb);
  asm volatile("s_waitcnt lgkmcnt(0)" ::: "memory"); SBAR();
#define PK(L, H) (bf16x8){L[0], L[1], L[2], L[3], H[0], H[1], H[2], H[3]}
  od = __builtin_amdgcn_mfma_f32_32x32x16_bf16(pa0, PK(l0, h0), od, 0, 0, 0);
  od = __builtin_amdgcn_mfma_f32_32x32x16_bf16(pa1, PK(l1, h1), od, 0, 0, 0);
  od = __builtin_amdgcn_mfma_f32_32x32x16_bf16(pa2, PK(l2, h2), od, 0, 0, 0);
  od = __builtin_amdgcn_mfma_f32_32x32x16_bf16(pa3, PK(l3, h3), od, 0, 0, 0);
#undef PK
}
__device__ __forceinline__ void pv_d0(f32x16* o, int vb, bf16x8 pa0, bf16x8 pa1, bf16x8 pa2, bf16x8 pa3) {
  pv_one<0>(o[0], vb, pa0, pa1, pa2, pa3); pv_one<1>(o[1], vb, pa0, pa1, pa2, pa3); pv_one<2>(o[2], vb, pa0, pa1, pa2, pa3); pv_one<3>(o[3], vb, pa0, pa1, pa2, pa3);
}
constexpr size_t SHM_V = 64 * 128 * 2, SHM_K = 64 * 128 * 2, SHM_ATTN = 2 * SHM_V + 2 * SHM_K + 8 * 64 * 4;
template <int MODE, int LDQ, int LDK, int LDO, int SDEPTH>
__device__ __forceinline__ void attn_body(const bf16_t* __restrict__ Qb, const bf16_t* __restrict__ Kh, const bf16_t* __restrict__ Vh, const bf16_t* __restrict__ Gb,
                                          bf16_t* __restrict__ Ob, const float* __restrict__ qnw, const int NT, const int tok0, const int r0, const int t0, char* lds, const int tid) {
  const int wid = __builtin_amdgcn_readfirstlane(tid >> 6), lane = tid & 63, r32 = lane & 31, hi = lane >> 5;
  bf16_t* V_lds = (bf16_t*)lds; bf16_t* K_lds = (bf16_t*)(lds + 2 * SHM_V);
  float* ws = (float*)(lds + 2 * SHM_V + 2 * SHM_K) + wid * 64; float* li_l = ws; float* al_l = ws + 32;
  const __attribute__((address_space(3))) float* biasT = (const __attribute__((address_space(3))) float*)(lds + SHM_ATTN) + 64;
  float m_reg = MODE ? -1e29f : -1e30f, l_reg = 0; f32x16 o[4] = {}; bf16x8 qr[8];
  char* qt = MODE ? lds + 73728 : lds;
  {
    const int prow_ = tid >> 1, half = tid & 1;
    const bf16_t* Qw = Qb + (long)prow_ * LDQ + half * 64;
    u32x4 raw[8]; float ss = 0.f;
#pragma unroll
    for (int j = 0; j < 8; ++j) { raw[j] = *reinterpret_cast<const u32x4*>(Qw + j * 8);
#pragma unroll
      for (int e = 0; e < 4; ++e) { const float a = lo2f(raw[j][e]), b = hi2f(raw[j][e]); ss += a * a + b * b; } }
    ss += __shfl_xor(ss, 1);
    const float rstd = rsqrtf(ss * (1.f / 128.f) + EPS);
    const int tok = tok0 + prow_; const float pos = half ? (float)(tok & 63) : (float)(tok >> 6);
#pragma unroll
    for (int j = 0; j < 8; ++j) {
      const f32x4 w0 = *reinterpret_cast<const f32x4*>(qnw + half * 64 + j * 8), w1 = *reinterpret_cast<const f32x4*>(qnw + half * 64 + j * 8 + 4);
      float v[8];
#pragma unroll
      for (int e = 0; e < 4; ++e) { v[2 * e] = lo2f(raw[j][e]) * rstd; v[2 * e + 1] = hi2f(raw[j][e]) * rstd; }
      v[0] *= w0[0]; v[1] *= w0[1]; v[2] *= w0[2]; v[3] *= w0[3]; v[4] *= w1[0]; v[5] *= w1[1]; v[6] *= w1[2]; v[7] *= w1[3];
      if (MODE == 0) {
#pragma unroll
        for (int e2 = 0; e2 < 4; ++e2) { const int i = j * 4 + e2;
          const float inv = exp2f(-(float)i * (13.287712379549449f / 32.f)); float sn, cs; sincos_rev(pos * inv, sn, cs);
          const float x1 = v[2 * e2], x2 = v[2 * e2 + 1]; v[2 * e2] = x1 * cs - x2 * sn; v[2 * e2 + 1] = x1 * sn + x2 * cs; } }
      u32x4 w = {pk2(v[0], v[1]), pk2(v[2], v[3]), pk2(v[4], v[5]), pk2(v[6], v[7])};
      *reinterpret_cast<u32x4*>(qt + KSWZ(prow_, (half * 64 + j * 8) * 2)) = w; }
    __syncthreads();
    if (MODE == 0) {
#pragma unroll
      for (int d0 = 0; d0 < 8; ++d0) qr[d0] = *reinterpret_cast<const bf16x8*>(lds + KSWZ(wid * 32 + r32, (d0 * 16 + hi * 8) * 2));
      __syncthreads(); }
  }
  const char* qrow = qt + (wid * 32 + r32) * 256;
  const int rq = r0 + (wid >> 1), qc = (wid & 1) * 32 + r32, rs = min(max(rq - 4, 0), 248), cs0 = min(max(qc - 8, 0), 48);
  const int mbase = 232 - rq * 31 - qc;
#define NA_INIT(P0, P1, J) do { if (MODE == 1) { const int kt = t0 + (J); \
    if ((kt >= rs) && (kt < rs + 8)) { int ib = mbase + kt * 31, csx = cs0; asm volatile("" : "+v"(ib), "+v"(csx)); \
      _Pragma("unroll") for (int r = 0; r < 16; ++r) { const int kc0 = crow(r, hi), kc1 = 32 + kc0; \
        const bool ok0 = (unsigned)(kc0 - csx) < 16u, ok1 = (unsigned)(kc1 - csx) < 16u; \
        const float b0 = biasT[ib + kc0], b1 = biasT[ib + kc1]; \
        P0[r] = ok0 ? b0 : -1e30f; P1[r] = ok1 ? b1 : -1e30f; } } \
    } } while (0)
#define TILE_OK(J) (MODE == 0 || ((t0 + (J)) >= rs && (t0 + (J)) < rs + 8))
#define QKT(P0, P1, KP, J, V) do { V = TILE_OK(J); if (V) { NA_INIT(P0, P1, J); qkt<MODE == 0, MODE == 1>(P0, P1, KP, qr, r32, hi, qrow); } } while (0)
#define PSM(P0, P1, MN, AL, V) do { if (V) partialSM(P0, P1, m_reg, MN, AL); else { MN = m_reg; AL = 1.f; } } while (0)
#define FSM_PV(P0, P1, AL, VB, V) do { if (V) { finishSM(P0, P1, AL, l_reg, pa0, pa1, pa2, pa3); SBAR(); } } while (0)
  const int sr = tid >> 4, sc = (tid & 15) * 8, vst0 = v_st(sr, sc), vst1 = v_st(32 + sr, sc);
  const int vb0 = (int)(uintptr_t)V_lds + v_rd_base(lane);
  struct { bf16x8 vs0, vs1, ks0, ks1; } sr_[SDEPTH];
#define LD8(p) (*reinterpret_cast<const bf16x8*>(p))
#define SLOAD(i, k0) do { sr_[i].vs0 = LD8(&Vh[(long)((k0) + sr) * LDK + sc]); sr_[i].vs1 = LD8(&Vh[(long)((k0) + 32 + sr) * LDK + sc]); \
    sr_[i].ks0 = LD8(&Kh[(long)((k0) + sr) * LDK + sc]); sr_[i].ks1 = LD8(&Kh[(long)((k0) + 32 + sr) * LDK + sc]); } while (0)
#define SWRITE(b, i) do { *(bf16x8*)((char*)V_lds + (b) * SHM_V + vst0) = sr_[i].vs0;          \
    *(bf16x8*)((char*)V_lds + (b) * SHM_V + vst1) = sr_[i].vs1; int kc = sc * 2;               \
    *(bf16x8*)((char*)K_lds + (b) * SHM_K + KSWZ(sr, kc)) = sr_[i].ks0;                       \
    *(bf16x8*)((char*)K_lds + (b) * SHM_K + KSWZ(32 + sr, kc)) = sr_[i].ks1; } while (0)
#define SWAIT() do { if constexpr (SDEPTH == 2) asm volatile("s_waitcnt vmcnt(4)" ::: "memory"); else asm volatile("s_waitcnt vmcnt(0)" ::: "memory"); } while (0)
#define RESC(a) do { if (__any((a) < 1.f)) { if (hi == 0) al_l[r32] = (a); asm volatile("s_waitcnt lgkmcnt(0)" ::: "memory"); \
    for (int d = 0; d < 4; ++d) for (int r = 0; r < 16; ++r) o[d][r] *= al_l[crow(r, hi)]; } } while (0)
  f32x16 pA0, pA1, pB0, pB1; float mnA, mnB, alA, alB; bf16x8 pa0, pa1, pa2, pa3;
  constexpr int SE = 0, SO = SDEPTH - 1, KVBLK = 64;
  bool vA = true, vB = true;
  SLOAD(SE, 0); asm volatile("s_waitcnt vmcnt(0)" ::: "memory"); SWRITE(0, SE); __syncthreads();
  QKT(pA0, pA1, K_lds, 0, vA); PSM(pA0, pA1, mnA, alA, vA);
  SLOAD(SO, KVBLK); if constexpr (SDEPTH == 2) { if (2 < NT) SLOAD(SE, 2 * KVBLK); }
  SWAIT(); SWRITE(1, SO); __syncthreads();
  for (int j = 1; j + 1 < NT; j += 2) {
    SBAR(); QKT(pB0, pB1, (bf16_t*)((char*)K_lds + SHM_K), j, vB);
    if (vA) finishSM(pA0, pA1, alA, l_reg, pa0, pa1, pa2, pa3); SBAR();
    SLOAD(SO, (j + SDEPTH) * KVBLK); SBAR();
    if (vA) pv_d0(o, vb0, pa0, pa1, pa2, pa3); PSM(pB0, pB1, mnB, alB, vB);
    __syncthreads(); SWAIT(); SWRITE(0, SE);
    RESC(alB); __syncthreads();
    SBAR(); QKT(pA0, pA1, K_lds, j + 1, vA);
    if (vB) finishSM(pB0, pB1, alB, l_reg, pa0, pa1, pa2, pa3); SBAR();
    if (SDEPTH == 1 || j + 3 < NT) SLOAD(SE, (j + 1 + SDEPTH) * KVBLK); SBAR();
    if (vB) pv_d0(o, vb0 + (int)SHM_V, pa0, pa1, pa2, pa3); PSM(pA0, pA1, mnA, alA, vA);
    __syncthreads(); SWAIT(); SWRITE(1, SO);
    RESC(alA); __syncthreads();
  }
  SBAR(); QKT(pB0, pB1, (bf16_t*)((char*)K_lds + SHM_K), NT - 1, vB);
  if (vA) finishSM(pA0, pA1, alA, l_reg, pa0, pa1, pa2, pa3); SBAR();
  if (vA) pv_d0(o, vb0, pa0, pa1, pa2, pa3); PSM(pB0, pB1, mnB, alB, vB);
  __syncthreads(); RESC(alB);
  if (vB) { finishSM(pB0, pB1, alB, l_reg, pa0, pa1, pa2, pa3); SBAR();
    pv_d0(o, vb0 + (int)SHM_V, pa0, pa1, pa2, pa3); }
  if (hi == 0) li_l[r32] = l_reg; asm volatile("s_waitcnt lgkmcnt(0)" ::: "memory");
  float rli[16];
#pragma unroll
  for (int r = 0; r < 16; ++r) rli[r] = __builtin_amdgcn_rcpf(li_l[crow(r, hi)]);
  __syncthreads();
  { bf16_t* Ot = (bf16_t*)lds + wid * 32 * 128;
#pragma unroll
    for (int r = 0; r < 16; ++r)
#pragma unroll
      for (int d0 = 0; d0 < 4; ++d0) Ot[crow(r, hi) * 128 + d0 * 32 + r32] = f2bf(o[d0][r] * rli[r]);
    WAVE_LDS_FENCE();
#pragma unroll 2
    for (int i = 0; i < 8; ++i) { const int id = lane + 64 * i, row = id >> 4, cc = id & 15;
      const u32x4 ov = *reinterpret_cast<const u32x4*>(Ot + row * 128 + cc * 8);
      const u32x4 gv = *reinterpret_cast<const u32x4*>(Gb + (long)(wid * 32 + row) * 1024 + cc * 8);
      u32x4 w;
#pragma unroll
      for (int e = 0; e < 4; ++e) w[e] = pk2(lo2f(ov[e]) * lo2f(gv[e]), hi2f(ov[e]) * hi2f(gv[e]));
      *reinterpret_cast<u32x4*>(Ob + (long)(wid * 32 + row) * LDO + cc * 8) = w; }
  }
#undef NA_INIT
#undef QKT
#undef PSM
#undef FSM_PV
#undef TILE_OK
#undef LD8
#undef SLOAD
#undef SWRITE
#undef SWAIT
#undef RESC
}
__device__ __forceinline__ void p0_transpose_item(const float* __restrict__ W, int N, int K, bf16_t* __restrict__ WT, int k0, int nrow0, int srccol0, float* scr, int lane,
                                                  int kd0 = -1, const float* __restrict__ kscale = nullptr) {
  if (kd0 < 0) kd0 = k0;
  if (srccol0 >= 0) {
    f32x4 v[8];
#pragma unroll
    for (int i = 0; i < 8; ++i) v[i] = *(const f32x4*)(W + (size_t)(k0 + 8 * i + (lane >> 3)) * N + srccol0 + (lane & 7) * 4);
    if (kscale) {
#pragma unroll
      for (int i = 0; i < 8; ++i) v[i] *= kscale[k0 + 8 * i + (lane >> 3)]; }
#pragma unroll
    for (int i = 0; i < 8; ++i) { float* s = scr + (8 * i + (lane >> 3)) * 33 + (lane & 7) * 4; s[0] = v[i][0]; s[1] = v[i][1]; s[2] = v[i][2]; s[3] = v[i][3]; }
  } else {
#pragma unroll 8
    for (int i = 0; i < 32; ++i) { const int kk = 2 * i + (lane >> 5); scr[kk * 33 + (lane & 31)] = 0.f; }
  }
  WAVE_LDS_FENCE();
  const int c = lane & 7;
#pragma unroll
  for (int j = 0; j < 4; ++j) { const int n = (lane >> 3) + 8 * j; const float* s = scr + (8 * c) * 33 + n;
    u32x4 o; o[0] = pk2(s[0 * 33], s[1 * 33]); o[1] = pk2(s[2 * 33], s[3 * 33]); o[2] = pk2(s[4 * 33], s[5 * 33]); o[3] = pk2(s[6 * 33], s[7 * 33]);
    *(u32x4*)(WT + (size_t)(nrow0 + n) * K + kd0 + 8 * c) = o; }
  WAVE_LDS_FENCE();
}
__device__ __forceinline__ void p0_phase(const Params& P, unsigned char* lds, int bid, int G, int tid, int wid, int lane) {
  unsigned char* ws = P.ws;
  float* red = (float*)lds; float* sc = (float*)(lds + 4096);
  if (bid < 192) { for (int k = tid; k < DM; k += 512) sc[k] = silu_f(P.c[k]); __syncthreads(); }
  for (int item = bid; item < 192; item += G) {
    const int layer = item / 96, cgi = item % 96;
    const float* W = layer ? P.o_ada_w : P.e_ada_w; const float* bias = layer ? P.o_ada_b : P.e_ada_b;
    f32x4 a4 = {0.f, 0.f, 0.f, 0.f}; const int k0 = wid * 256 + (lane >> 4), c4 = cgi * 64 + (lane & 15) * 4;
#pragma unroll 8
    for (int k = 0; k < 256; k += 4) a4 += *(const f32x4*)(W + (size_t)(k0 + k) * 6144 + c4) * sc[k0 + k];
#pragma unroll
    for (int e = 0; e < 4; ++e) { a4[e] += __shfl_xor(a4[e], 16); a4[e] += __shfl_xor(a4[e], 32); }
    if (lane < 16) *(f32x4*)(red + wid * 64 + lane * 4) = a4;
    __syncthreads();
    if (tid < 64) { float s = 0.f;
#pragma unroll
      for (int i = 0; i < 8; ++i) s += red[i * 64 + tid];
      ((float*)(ws + O_MOD))[layer * 6144 + cgi * 64 + tid] = s + bias[cgi * 64 + tid]; }
    __syncthreads();
  }
  float* scr = (float*)(lds + 16384 + wid * 8448);
  const int gw = bid * 8 + wid, ngw = G * 8;
  constexpr int I0 = 32 * 144, I1 = 16 * 64, I2 = 32 * 64, I3 = 0, I4 = 32 * 64;
  for (int it = gw; it < I0 + I1 + I2 + I3 + I4; it += ngw) {
    int r = it;
    if (r < I0) { const int kb = r / 144, nb = r % 144; p0_transpose_item(P.e_w_in, 4608, 2048, (bf16_t*)(ws + O_WT_IN_E), 64 * kb, 32 * nb, 32 * nb, scr, lane); continue; } r -= I0;
    if (r < I1) { const int kb = r / 64, nb = r % 64, n0 = 32 * nb, pn = n0 >> 8, bj = (n0 >> 7) & 1, j0 = n0 & 127;
                  p0_transpose_item(P.s5_w_glu, 2048, 1024, (bf16_t*)(ws + O_WT_GLU), 64 * kb, n0, 1024 * bj + 128 * pn + j0, scr, lane); continue; } r -= I1;
    if (r < I2) { const int kb = r / 64, nb = r % 64; p0_transpose_item(P.e_w_out, 2048, 2048, (bf16_t*)(ws + O_WT_OUT_E), 64 * kb, 32 * nb, 32 * nb, scr, lane); continue; } r -= I2;
    { const int kb = r / 64, nb = r % 64, k0 = 64 * kb;
      p0_transpose_item(P.o_w_out, 2048, 2048, (bf16_t*)(ws + O_WT_OUT_O), k0, 32 * nb, 32 * nb, scr, lane, (k0 + 1024) & 2047, k0 >= 1024 ? P.ssd_norm_w - 1024 : nullptr); }
  }
  for (int i = bid * 512 + tid; i < L + 6912; i += G * 512) { if (i < L) ((float*)(ws + O_SSQ1))[i] = 0.f; else ((float*)(ws + O_SWO))[i - L] = 0.f; }
  for (int idx = bid * 512 + tid; idx < 2 * 64 * 64; idx += G * 512) {
    const int dg = idx >> 6, p = idx & 63;
    const float lr = P.s5_lam_re[idx], li = P.s5_lam_im[idx], dt = __expf(P.s5_log_step[dg]);
    const float mag = __expf(lr * dt); float sn, cs; sincos_rev(li * dt, sn, cs);
    const float abr = mag * cs, abi = mag * sn, den = lr * lr + li * li, nr = abr - 1.f;
    const float fr = (nr * lr + abi * li) / den, fi = (abi * lr - nr * li) / den;
    float* ab = (float*)(ws + O_AB); ab[idx * 2] = abr; ab[idx * 2 + 1] = abi;
    bf16_t* bbar = (bf16_t*)(ws + O_BBAR); bf16_t* cmat = (bf16_t*)(ws + O_CMAT);
    for (int i = 0; i < 16; ++i) { const float br = P.s5_b_re[(size_t)idx * 16 + i], bi = P.s5_b_im[(size_t)idx * 16 + i];
      bbar[((size_t)dg * 128 + p) * 16 + i] = f2bf(fr * br - fi * bi); bbar[((size_t)dg * 128 + 64 + p) * 16 + i] = f2bf(fr * bi + fi * br); }
    for (int ch = 0; ch < 16; ++ch) { const float cr = P.s5_c_re[((size_t)dg * 16 + ch) * 64 + p], ci = P.s5_c_im[((size_t)dg * 16 + ch) * 64 + p];
      cmat[((size_t)dg * 16 + ch) * 128 + p] = f2bf(cr); cmat[((size_t)dg * 16 + ch) * 128 + 64 + p] = f2bf(-ci); }
  }
}
__device__ __forceinline__ void w_in_o_phase(const Params& P, unsigned char* lds, int gw, int ngw, int wid, int lane) {
  const float* mod1 = (const float*)(P.ws + O_MOD) + 6144; float* sW = (float*)(P.ws + O_SWO);
  const float* W = P.o_w_in; bf16_t* WT = (bf16_t*)(P.ws + O_WT_IN_O); constexpr int N = 6688, K = 2048;
  float* scr = (float*)(lds + 16384 + wid * 8448);
  for (int it = gw; it < 32 * 216; it += ngw) {
    const int kb = it / 216, nb = it % 216, k0 = 64 * kb, n0 = 32 * nb;
    if (n0 < N) {
      f32x4 v[8]; f32x4 ps = {0.f, 0.f, 0.f, 0.f};
#pragma unroll
      for (int i = 0; i < 8; ++i) v[i] = *(const f32x4*)(W + (size_t)(k0 + 8 * i + (lane >> 3)) * N + n0 + (lane & 7) * 4);
#pragma unroll
      for (int i = 0; i < 8; ++i) { const int k = k0 + 8 * i + (lane >> 3); const float sh = mod1[k], a = P.o_norm_g[k] * (1.f + mod1[2048 + k]);
        ps += v[i] * sh; v[i] *= a; }
#pragma unroll
      for (int e = 0; e < 4; ++e) { ps[e] += __shfl_xor(ps[e], 8); ps[e] += __shfl_xor(ps[e], 16); ps[e] += __shfl_xor(ps[e], 32); }
      if ((lane >> 3) == 0) {
#pragma unroll
        for (int e = 0; e < 4; ++e) atomicAdd(sW + n0 + (lane & 7) * 4 + e, ps[e]); }
#pragma unroll
      for (int i = 0; i < 8; ++i) { float* s = scr + (8 * i + (lane >> 3)) * 33 + (lane & 7) * 4; s[0] = v[i][0]; s[1] = v[i][1]; s[2] = v[i][2]; s[3] = v[i][3]; }
    } else {
#pragma unroll 8
      for (int i = 0; i < 32; ++i) { const int kk = 2 * i + (lane >> 5); scr[kk * 33 + (lane & 31)] = 0.f; }
    }
    WAVE_LDS_FENCE();
    const int c = lane & 7;
#pragma unroll
    for (int j = 0; j < 4; ++j) { const int n = (lane >> 3) + 8 * j; const float* s = scr + (8 * c) * 33 + n;
      u32x4 o; o[0] = pk2(s[0 * 33], s[1 * 33]); o[1] = pk2(s[2 * 33], s[3 * 33]); o[2] = pk2(s[4 * 33], s[5 * 33]); o[3] = pk2(s[6 * 33], s[7 * 33]);
      *(u32x4*)(WT + (size_t)(n0 + n) * K + k0 + 8 * c) = o; }
    WAVE_LDS_FENCE();
  }
}
__device__ __forceinline__ void norm_mod_phase(const float* __restrict__ X, const float* __restrict__ g, const float* __restrict__ mod, bf16_t* __restrict__ H, int gw, int ngw, int lane) {
  for (int row = gw; row < L; row += ngw) {
    const f32x4* xr = (const f32x4*)(X + (size_t)row * DM) + lane;
    f32x4 v[8]; float ss = 0.f;
#pragma unroll
    for (int j = 0; j < 8; ++j) { v[j] = xr[64 * j]; ss += v[j][0] * v[j][0] + v[j][1] * v[j][1] + v[j][2] * v[j][2] + v[j][3] * v[j][3]; }
    const float rstd = rsqrtf(wave_sum(ss) * (1.f / DM) + EPS);
#pragma unroll
    for (int j = 0; j < 8; ++j) { const int col = (lane + 64 * j) * 4;
      const f32x4 g4 = *(const f32x4*)(g + col), sh = *(const f32x4*)(mod + col), sc4 = *(const f32x4*)(mod + DM + col);
      f32x4 o = v[j] * rstd * g4 * (sc4 + 1.f) + sh;
      u32x2 w = {pk2(o[0], o[1]), pk2(o[2], o[3])};
      *(u32x2*)(H + (size_t)row * DM + col) = w; }
  }
}
__device__ __forceinline__ void kprep_gqa_phase(const Params& P, int gw, int ngw, int lane) {
  const bf16_t* kr = (const bf16_t*)(P.ws + O_KR); bf16_t* kn = (bf16_t*)(P.ws + O_KN);
  const int sub = lane & 15, rsel = lane >> 4;
  const f32x4 w0 = *(const f32x4*)(P.e_k_norm + sub * 8), w1 = *(const f32x4*)(P.e_k_norm + sub * 8 + 4);
  float inv[4];
#pragma unroll
  for (int e = 0; e < 4; ++e) inv[e] = exp2f(-(float)((sub * 4 + e) & 31) * (13.287712379549449f / 32.f));
  for (int r0 = gw * 16; r0 < L * 2; r0 += ngw * 16) {
    u32x4 w[4];
#pragma unroll
    for (int k = 0; k < 4; ++k) w[k] = *(const u32x4*)(kr + (size_t)(r0 + k * 4 + rsel) * 128 + sub * 8);
#pragma unroll
    for (int k = 0; k < 4; ++k) { const int row = r0 + k * 4 + rsel, tok = row >> 1; float v[8]; float ss = 0.f;
#pragma unroll
      for (int e = 0; e < 4; ++e) { v[2 * e] = lo2f(w[k][e]); v[2 * e + 1] = hi2f(w[k][e]); ss += v[2 * e] * v[2 * e] + v[2 * e + 1] * v[2 * e + 1]; }
      ss += __shfl_xor(ss, 1); ss += __shfl_xor(ss, 2); ss += __shfl_xor(ss, 4); ss += __shfl_xor(ss, 8);
      const float rstd = rsqrtf(ss * (1.f / 128.f) + EPS);
      v[0] *= rstd * w0[0]; v[1] *= rstd * w0[1]; v[2] *= rstd * w0[2]; v[3] *= rstd * w0[3]; v[4] *= rstd * w1[0]; v[5] *= rstd * w1[1]; v[6] *= rstd * w1[2]; v[7] *= rstd * w1[3];
      const float pos = sub < 8 ? (float)(tok >> 6) : (float)(tok & 63);
      u32x4 o;
#pragma unroll
      for (int e = 0; e < 4; ++e) { float sn, cs; sincos_rev(pos * inv[e], sn, cs); o[e] = pk2(v[2 * e] * cs - v[2 * e + 1] * sn, v[2 * e] * sn + v[2 * e + 1] * cs); }
      *(u32x4*)(kn + (size_t)row * 128 + sub * 8) = o; }
  }
}
template <bool PASS2, int DIR>
__device__ __forceinline__ void s5_sub(const bf16x8 ufr, const bf16x8 (&bfr)[8], const bf16x8 (&cfr)[4], float ar, float ai, float& hr, float& hi, f32x4& ya,
                                       float* XS, bf16_t* HS, int lane) {
  const int n = lane & 15, kq = lane >> 4;
  const bf16x8 zero8 = {0, 0, 0, 0, 0, 0, 0, 0}; const f32x4 zero4 = {0.f, 0.f, 0.f, 0.f};
#pragma unroll
  for (int jt = 0; jt < 8; ++jt) { const f32x4 xv = mfma16(ufr, bfr[jt], zero4);
#pragma unroll
    for (int r = 0; r < 4; ++r) XS[(kq * 4 + r) * 132 + jt * 16 + n] = xv[r]; }
  WAVE_LDS_FENCE();
  float xr_[16], xi_[16];
#pragma unroll
  for (int tt = 0; tt < 16; ++tt) { const int t = DIR ? 15 - tt : tt; xr_[tt] = XS[t * 132 + lane]; xi_[tt] = XS[t * 132 + 64 + lane]; }
  WAVE_LDS_FENCE(); __builtin_amdgcn_sched_barrier(0);
#pragma unroll
  for (int tt = 0; tt < 16; ++tt) { const int t = DIR ? 15 - tt : tt; const float xr = xr_[tt], xi = xi_[tt];
    const float nr = ar * hr - ai * hi + xr, ni = ar * hi + ai * hr + xi; hr = nr; hi = ni;
    if (PASS2) { const unsigned pk = pk2(hr, hi); HS[t * 136 + lane] = (bf16_t)(pk & 0xffffu); HS[t * 136 + 64 + lane] = (bf16_t)(pk >> 16); } }
  WAVE_LDS_FENCE();
  if (PASS2) {
    bf16x8 ha[4];
#pragma unroll
    for (int ks = 0; ks < 4; ++ks) ha[ks] = *(const bf16x8*)(HS + n * 136 + ks * 32 + kq * 8);
#pragma unroll
    for (int ks = 0; ks < 4; ++ks) ya = mfma16(ha[ks], cfr[ks], ya);
    WAVE_LDS_FENCE();
  }
}
template <bool PASS2, int DIR>
__device__ __forceinline__ void s5_dir(const Params& P, int c, int g, float* XS, bf16_t* HS, int lane, f32x4 (&yacc)[8], const bf16x8 (&ufr)[8]) {
  const int dg = DIR * 64 + g, n = lane & 15, kq = lane >> 4;
  const bf16_t* bbar = (const bf16_t*)(P.ws + O_BBAR); const bf16_t* cmat = (const bf16_t*)(P.ws + O_CMAT); const float* ab = (const float*)(P.ws + O_AB);
  const bf16_t* U = (const bf16_t*)(P.ws + O_RA + 2 * SZ_LK); float* s5e = (float*)(P.ws + O_S5E);
  const bf16x8 zero8 = {0, 0, 0, 0, 0, 0, 0, 0}; const f32x4 zero4 = {0.f, 0.f, 0.f, 0.f};
  bf16x8 bfr[8];
#pragma unroll
  for (int jt = 0; jt < 8; ++jt) { bfr[jt] = zero8; if (kq < 2) bfr[jt] = *(const bf16x8*)(bbar + ((size_t)dg * 128 + jt * 16 + n) * 16 + kq * 8); }
  const float ar = ab[(dg * 64 + lane) * 2], ai = ab[(dg * 64 + lane) * 2 + 1];
  float hr = 0.f, hi = 0.f;
  bf16x8 cfr[4] = {zero8, zero8, zero8, zero8};
  if (PASS2) {
#pragma unroll
    for (int ks = 0; ks < 4; ++ks) cfr[ks] = *(const bf16x8*)(cmat + ((size_t)dg * 16 + n) * 128 + ks * 32 + kq * 8);
    float tr = ar, ti = ai;
#pragma unroll
    for (int i = 0; i < 7; ++i) { const float nr = tr * tr - ti * ti, ni = 2.f * tr * ti; tr = nr; ti = ni; }
    { const float* e = s5e + ((size_t)(c * 64 + g) * 2 + DIR) * 128; hr = e[lane]; hi = e[64 + lane]; }
  }
  f32x4 dummy = zero4;
#pragma unroll
  for (int s = 0; s < 8; ++s) { const int sb = DIR ? 7 - s : s;
    s5_sub<PASS2, DIR>(ufr[sb], bfr, cfr, ar, ai, hr, hi, PASS2 ? yacc[sb] : dummy, XS, HS, lane);
    __builtin_amdgcn_sched_barrier(0); }
  if (!PASS2) { float* e = s5e + ((size_t)(c * 64 + g) * 2 + DIR) * 128; e[lane] = hr; e[64 + lane] = hi; }
}
__device__ __forceinline__ void s5_carry_phase(const Params& P, int bid, int G, int wid, int lane) {
  float* s5e = (float*)(P.ws + O_S5E); const float* ab = (const float*)(P.ws + O_AB);
  if (wid != 0) return;
  for (int seq = bid; seq < 128; seq += G) {
    const int g = seq & 63, dir = seq >> 6, dg = dir * 64 + g;
    float tr = ab[(dg * 64 + lane) * 2], ti = ab[(dg * 64 + lane) * 2 + 1];
#pragma unroll
    for (int i = 0; i < 7; ++i) { const float nr = tr * tr - ti * ti, ni = 2.f * tr * ti; tr = nr; ti = ni; }
    float hr = 0.f, hi = 0.f;
#pragma unroll 1
    for (int ib = 0; ib < NCH; ib += 16) { float er[16], ei[16];
#pragma unroll
      for (int k = 0; k < 16; ++k) { const int c = dir ? NCH - 1 - (ib + k) : ib + k; const float* e = s5e + ((size_t)(c * 64 + g) * 2 + dir) * 128; er[k] = e[lane]; ei[k] = e[64 + lane]; }
#pragma unroll
      for (int k = 0; k < 16; ++k) { const int c = dir ? NCH - 1 - (ib + k) : ib + k; float* e = s5e + ((size_t)(c * 64 + g) * 2 + dir) * 128;
        e[lane] = hr; e[64 + lane] = hi;
        const float nr = tr * hr - ti * hi + er[k], ni = tr * hi + ti * hr + ei[k]; hr = nr; hi = ni; }
    }
  }
}
template <bool PASS2>
__device__ __forceinline__ void s5_phase(const Params& P, unsigned char* lds, int gw, int ngw, int wid, int lane) {
  float* XS = (float*)(lds + wid * 8448); bf16_t* HS = (bf16_t*)(lds + 8 * 8448 + wid * 4352);
  const bf16_t* U = (const bf16_t*)(P.ws + O_RA + 2 * SZ_LK); bf16_t* Y = (bf16_t*)(P.ws + O_Y);
  for (int task = gw; task < NCH * 64; task += ngw) {
    const int c = task >> 6, g = task & 63;
    f32x4 yacc[8];
#pragma unroll
    for (int i = 0; i < 8; ++i) yacc[i] = (f32x4){0.f, 0.f, 0.f, 0.f};
    bf16x8 ufr[8];
#pragma unroll
    for (int sb = 0; sb < 8; ++sb) { ufr[sb] = (bf16x8){0, 0, 0, 0, 0, 0, 0, 0};
      if ((lane >> 4) < 2) ufr[sb] = *(const bf16x8*)(U + (size_t)(c * 128 + sb * 16 + (lane & 15)) * 1024 + g * 16 + (lane >> 4) * 8); }
    s5_dir<PASS2, 0>(P, c, g, XS, HS, lane, yacc, ufr);
    s5_dir<PASS2, 1>(P, c, g, XS, HS, lane, yacc, ufr);
    if (PASS2) {
      const int n = lane & 15, kq = lane >> 4, ch = g * 16 + n; const float dd = P.s5_d[ch];
#pragma unroll
      for (int sb = 0; sb < 8; ++sb)
#pragma unroll
        for (int r = 0; r < 4; ++r) { const size_t t = (size_t)c * 128 + sb * 16 + kq * 4 + r;
          const float y = yacc[sb][r] + dd * bf2f(U[t * 1024 + ch]);
          const float z = 0.7978845608028654f * (y + 0.044715f * y * y * y);
          const float th = 1.f - 2.f * __builtin_amdgcn_rcpf(1.f + __expf(2.f * z));
          Y[t * 1024 + ch] = f2bf(0.5f * y * (1.f + th)); }
    }
  }
}
__device__ __forceinline__ void prep1_phase(const Params& P, unsigned char* lds, int gw, int ngw, int wid, int lane, bool do_knorm) {
  unsigned char* ws = P.ws;
  if (do_knorm) { bf16_t* K = (bf16_t*)(ws + O_RA + SZ_LK); const int sub = lane & 15, rsel = lane >> 4;
    const f32x4 w0 = *(const f32x4*)(P.o_k_norm + sub * 8), w1 = *(const f32x4*)(P.o_k_norm + sub * 8 + 4);
    for (int r0 = gw * 16; r0 < L * 8; r0 += ngw * 16) {
      u32x4 w[4];
#pragma unroll
      for (int k = 0; k < 4; ++k) w[k] = *(const u32x4*)(K + (size_t)(r0 + k * 4 + rsel) * 128 + sub * 8);
#pragma unroll
      for (int k = 0; k < 4; ++k) { float v[8]; float ss = 0.f;
#pragma unroll
        for (int e = 0; e < 4; ++e) { v[2 * e] = lo2f(w[k][e]); v[2 * e + 1] = hi2f(w[k][e]); ss += v[2 * e] * v[2 * e] + v[2 * e + 1] * v[2 * e + 1]; }
        ss += __shfl_xor(ss, 1); ss += __shfl_xor(ss, 2); ss += __shfl_xor(ss, 4); ss += __shfl_xor(ss, 8);
        const float rstd = rsqrtf(ss * (1.f / 128.f) + EPS);
        u32x4 o; o[0] = pk2(v[0] * rstd * w0[0], v[1] * rstd * w0[1]); o[1] = pk2(v[2] * rstd * w0[2], v[3] * rstd * w0[3]);
        o[2] = pk2(v[4] * rstd * w1[0], v[5] * rstd * w1[1]); o[3] = pk2(v[6] * rstd * w1[2], v[7] * rstd * w1[3]);
        *(u32x4*)(K + (size_t)(r0 + k * 4 + rsel) * 128 + sub * 8) = o; } } }
  { const bf16_t* xr = (const bf16_t*)(ws + O_XBCR); bf16_t* xc = (bf16_t*)(ws + O_XBCC); bf16_t* xt = (bf16_t*)(ws + O_XBCT);
    bf16_t* RAW = (bf16_t*)(lds + wid * 17920); bf16_t* TS = RAW + 68 * 64;
    for (int it = gw; it < 256 * 24; it += ngw) {
      const int tb = it / 24, cb = it % 24, t0 = tb * 64, ch = cb * 64 + lane;
#pragma unroll
      for (int i = 0; i < 9; ++i) { const int id = lane + 64 * i;
        if (id < 544) { const int r = id >> 3, cc = id & 7, t = t0 - 2 + r; u32x4 v = {0u, 0u, 0u, 0u};
          if (t >= 0 && t < L) v = *(const u32x4*)(xr + (size_t)t * 1536 + cb * 64 + cc * 8);
          *(u32x4*)(RAW + r * 64 + cc * 8) = v; } }
      const float w0 = P.ssd_conv_w[0 * 1536 + ch], w1 = P.ssd_conv_w[1 * 1536 + ch], w2 = P.ssd_conv_w[2 * 1536 + ch], w3 = P.ssd_conv_w[3 * 1536 + ch], w4 = P.ssd_conv_w[4 * 1536 + ch];
      const float cb_ = P.ssd_conv_b[ch];
      WAVE_LDS_FENCE();
      float a0 = bf2f(RAW[0 * 64 + lane]), a1 = bf2f(RAW[1 * 64 + lane]), a2 = bf2f(RAW[2 * 64 + lane]), a3 = bf2f(RAW[3 * 64 + lane]);
#pragma unroll 1
      for (int i0 = 0; i0 < 64; i0 += 8) { float nx[8];
#pragma unroll
        for (int k = 0; k < 8; ++k) nx[k] = bf2f(RAW[(i0 + k + 4) * 64 + lane]);
#pragma unroll
        for (int k = 0; k < 8; ++k) { const float a4 = nx[k];
          const float v = silu_f(w0 * a0 + w1 * a1 + w2 * a2 + w3 * a3 + w4 * a4 + cb_);
          const bf16_t b = f2bf(v); RAW[(i0 + k) * 64 + lane] = b; TS[lane * 72 + i0 + k] = b;
          a0 = a1; a1 = a2; a2 = a3; a3 = a4; } }
      WAVE_LDS_FENCE();
      if (cb >= 16) {
#pragma unroll
        for (int j = 0; j < 8; ++j) { const int id = lane + 64 * j, r = id >> 3, cc = id & 7;
          *(u32x4*)(xc + (size_t)(t0 + r) * 1536 + cb * 64 + cc * 8) = *(const u32x4*)(RAW + r * 64 + cc * 8); } }
      if (cb < 20) {
#pragma unroll
        for (int j = 0; j < 8; ++j) { const int r = (lane >> 3) + 8 * j, cc = lane & 7;
          *(u32x4*)(xt + (size_t)(cb * 64 + r) * L + t0 + cc * 8) = *(const u32x4*)(TS + r * 72 + cc * 8); } }
      WAVE_LDS_FENCE();
    } }
  { const float* dtr = (const float*)(ws + O_DTR); float* dt = (float*)(ws + O_DT); float* cum = (float*)(ws + O_CUM); float* tot = (float*)(ws + O_TOT);
    __syncthreads();
    float* A = (float*)(lds + wid * 16896);
    for (int c = gw; c < NCH; c += ngw) {
      const int col4 = (lane & 7) * 4; f32x4 bb, aa;
#pragma unroll
      for (int e = 0; e < 4; ++e) { bb[e] = P.ssd_dt_bias[col4 + e]; aa[e] = -__expf(P.ssd_a_log[col4 + e]); }
#pragma unroll 4
      for (int i = 0; i < 16; ++i) { const int t = i * 8 + (lane >> 3);
        const f32x4 v = *(const f32x4*)(dtr + ((size_t)c * 128 + t) * 32 + col4); f32x4 d;
#pragma unroll
        for (int e = 0; e < 4; ++e) { const float x = v[e] + bb[e]; d[e] = x > 20.f ? x : log1pf(__expf(x)); A[t * 33 + col4 + e] = d[e] * aa[e]; }
        *(f32x4*)(dt + ((size_t)c * 128 + t) * 32 + col4) = d; }
      WAVE_LDS_FENCE();
      if (lane < 32) { float cs = 0.f;
#pragma unroll 8
        for (int i = 0; i < 128; ++i) { const int t = lane < 16 ? i : 127 - i; cs += A[t * 33 + lane]; A[t * 33 + lane] = cs; }
        tot[c * 32 + lane] = cs; }
      WAVE_LDS_FENCE();
#pragma unroll 4
      for (int i = 0; i < 16; ++i) { const int t = i * 8 + (lane >> 3); f32x4 o;
#pragma unroll
        for (int e = 0; e < 4; ++e) o[e] = A[t * 33 + col4 + e];
        *(f32x4*)(cum + ((size_t)c * 128 + t) * 32 + col4) = o; }
      WAVE_LDS_FENCE();
    } }
}
__device__ __forceinline__ void ssd1_phase(const Params& P, unsigned char* lds, int bid, int G, int tid, int wid, int lane) {
  unsigned char* ws = P.ws;
  const bf16_t* xt = (const bf16_t*)(ws + O_XBCT); const float* dt = (const float*)(ws + O_DT); const float* cum = (const float*)(ws + O_CUM);
  bf16_t* ST = (bf16_t*)(ws + O_H);
  bf16_t* BT = (bf16_t*)lds; bf16_t* XF = (bf16_t*)(lds + 34816); bf16_t* XB = (bf16_t*)(lds + 34816 + 17408); float* wFa = (float*)(lds + 34816 + 2 * 17408); float* wBa = wFa + 8 * 128;
  for (int u = bid; u < NCH * 2; u += G) {
    const int c = u >> 1, gr = u & 1;
    __syncthreads();
#pragma unroll
    for (int i = 0; i < 4; ++i) { const int ch = tid + 512 * i, r = ch >> 4, cc = ch & 15;
      *(u32x4*)(BT + r * 136 + cc * 8) = *(const u32x4*)(xt + (size_t)(1024 + gr * 128 + r) * L + c * 128 + cc * 8); }
    { const int l = tid & 127, hq = tid >> 7; const size_t t = (size_t)c * 128 + l;
#pragma unroll
      for (int k = 0; k < 2; ++k) { const int hh = hq + 4 * k, h = gr * 8 + hh;
        wFa[hh * 128 + l] = dt[t * 32 + h] * __expf(cum[((size_t)c * 128 + 127) * 32 + h] - cum[t * 32 + h]);
        wBa[hh * 128 + l] = dt[t * 32 + 16 + h] * __expf(cum[((size_t)c * 128) * 32 + 16 + h] - cum[t * 32 + 16 + h]); } }
    __syncthreads();
    u32x4 wx[2];
#pragma unroll
    for (int i = 0; i < 2; ++i) { const int ch = tid + 512 * i, r = ch >> 4, cc = ch & 15; wx[i] = *(const u32x4*)(xt + (size_t)(gr * 8 * 64 + r) * L + c * 128 + cc * 8); }
#pragma unroll 1
    for (int hh = 0; hh < 8; ++hh) {
      const int h = gr * 8 + hh;
      const float* wF = wFa + hh * 128; const float* wB = wBa + hh * 128;
#pragma unroll
      for (int i = 0; i < 2; ++i) { const int ch = tid + 512 * i, r = ch >> 4, cc = ch & 15;
        const u32x4 w = wx[i];
        u32x4 of, ob;
#pragma unroll
        for (int e = 0; e < 4; ++e) { const float x0 = lo2f(w[e]), x1 = hi2f(w[e]); const int l0 = cc * 8 + 2 * e;
          of[e] = pk2(x0 * wF[l0], x1 * wF[l0 + 1]); ob[e] = pk2(x0 * wB[l0], x1 * wB[l0 + 1]); }
        *(u32x4*)(XF + r * 136 + cc * 8) = of; *(u32x4*)(XB + r * 136 + cc * 8) = ob; }
      __syncthreads();
      if (hh + 1 < 8) {
#pragma unroll
        for (int i = 0; i < 2; ++i) { const int ch = tid + 512 * i, r = ch >> 4, cc = ch & 15; wx[i] = *(const u32x4*)(xt + (size_t)((h + 1) * 64 + r) * L + c * 128 + cc * 8); } }
      { const int dir = wid >> 2, pt = wid & 3; const bf16_t* XS = dir ? XB : XF;
        f32x4 acc[8];
#pragma unroll
        for (int i = 0; i < 8; ++i) acc[i] = (f32x4){0.f, 0.f, 0.f, 0.f};
#pragma unroll
        for (int ks = 0; ks < 4; ++ks) { const bf16x8 a = ldfrag(XS, 136, 16 * pt, ks * 32, lane); bf16x8 bb[8];
#pragma unroll
          for (int nt = 0; nt < 8; ++nt) bb[nt] = ldfrag(BT, 136, 16 * nt, ks * 32, lane);
#pragma unroll
          for (int nt = 0; nt < 8; ++nt) acc[nt] = mfma16(a, bb[nt], acc[nt]); }
        bf16_t* dst = ST + (((size_t)c * 16 + h) * 2 + dir) * 8192;
#pragma unroll
        for (int nt = 0; nt < 8; ++nt)
#pragma unroll
          for (int r = 0; r < 4; ++r) dst[(16 * pt + (lane >> 4) * 4 + r) * 128 + 16 * nt + (lane & 15)] = f2bf(acc[nt][r]); }
      __syncthreads();
    }
  }
}
__device__ __forceinline__ void ssd_carry_phase(const Params& P, int bid, int G, int tid) {
  bf16_t* ST = (bf16_t*)(P.ws + O_H); const float* tot = (const float*)(P.ws + O_TOT);
  for (int e2 = bid * 512 + tid; e2 < 16 * 2 * 8192 / 2; e2 += G * 512) {
    const int e = e2 * 2, h = e >> 14, dir = (e >> 13) & 1;
    float r0 = 0.f, r1 = 0.f;
#pragma unroll 1
    for (int ib = 0; ib < NCH; ib += 16) {
      unsigned w[16]; float dec[16];
#pragma unroll
      for (int k = 0; k < 16; ++k) { const int c = dir ? NCH - 1 - (ib + k) : ib + k;
        w[k] = *(const unsigned*)(ST + (size_t)c * 262144 + e); dec[k] = tot[c * 32 + dir * 16 + h]; }
#pragma unroll
      for (int k = 0; k < 16; ++k) { const int c = dir ? NCH - 1 - (ib + k) : ib + k;
        *(unsigned*)(ST + (size_t)c * 262144 + e) = pk2(r0, r1);
        const float d = __expf(dec[k]); r0 = r0 * d + lo2f(w[k]); r1 = r1 * d + hi2f(w[k]); }
    }
  }
}
__device__ __forceinline__ void ssd2_phase(const Params& P, unsigned char* lds, int bid, int G, int tid, int wid, int lane) {
  unsigned char* ws = P.ws;
  const bf16_t* xc = (const bf16_t*)(ws + O_XBCC); const bf16_t* xt = (const bf16_t*)(ws + O_XBCT); const bf16_t* zs = (const bf16_t*)(ws + O_ZS);
  const float* dt = (const float*)(ws + O_DT); const float* cum = (const float*)(ws + O_CUM); const bf16_t* ST = (const bf16_t*)(ws + O_H);
  bf16_t* oc = (bf16_t*)(ws + O_OA); float* ssq = (float*)(ws + O_SSQ);
  bf16_t* Cs = (bf16_t*)lds; bf16_t* Bs = (bf16_t*)(lds + 34816); bf16_t* XT = (bf16_t*)(lds + 2 * 34816); bf16_t* Sf = (bf16_t*)(lds + 2 * 34816 + 17408);
  bf16_t* Sb = (bf16_t*)(lds + 2 * 34816 + 2 * 17408); float* cF = (float*)(lds + 2 * 34816 + 3 * 17408); float* dF = cF + 128; float* cB = cF + 256; float* dB = cF + 384;
  bf16_t* ZT = (bf16_t*)(lds + 2 * 34816 + 3 * 17408 + 2048);
  bf16_t* Ms = Bs + wid * 16 * 136;
  const int n = lane & 15, kq = lane >> 4;
  for (int u = bid; u < NCH * 2; u += G) {
    const int c = u >> 1, gr = u & 1;
    __syncthreads();
#pragma unroll
    for (int i = 0; i < 4; ++i) { const int ch = tid + 512 * i, r = ch >> 4, cc = ch & 15; const size_t t = (size_t)c * 128 + r;
      *(u32x4*)(Bs + r * 136 + cc * 8) = *(const u32x4*)(xc + t * 1536 + 1024 + gr * 128 + cc * 8);
      *(u32x4*)(Cs + r * 136 + cc * 8) = *(const u32x4*)(xc + t * 1536 + 1280 + gr * 128 + cc * 8); }
    __syncthreads();
    bf16x8 ca[4]; f32x4 gacc[8];
#pragma unroll
    for (int ks = 0; ks < 4; ++ks) ca[ks] = ldfrag(Cs, 136, 16 * wid, ks * 32, lane);
#pragma unroll
    for (int tc = 0; tc < 8; ++tc) { gacc[tc] = (f32x4){0.f, 0.f, 0.f, 0.f};
#pragma unroll
      for (int ks = 0; ks < 4; ++ks) gacc[tc] = mfma16(ca[ks], ldfrag(Bs, 136, 16 * tc, ks * 32, lane), gacc[tc]); }
    u32x4 px[2], pf[2], pb[2], pz[2]; float pc0 = 0.f, pc1 = 0.f, pc2 = 0.f, pc3 = 0.f;
    float sqh[4] = {0.f, 0.f, 0.f, 0.f};
#define SSD2_FETCH(H) do { _Pragma("unroll") for (int i = 0; i < 2; ++i) { const int ch = tid + 512 * i, r = ch >> 4, cc = ch & 15; \
        px[i] = *(const u32x4*)(xt + (size_t)((H) * 64 + r) * L + c * 128 + cc * 8); \
        pf[i] = *(const u32x4*)(ST + (((size_t)c * 16 + (H)) * 2 + 0) * 8192 + r * 128 + cc * 8); \
        pb[i] = *(const u32x4*)(ST + (((size_t)c * 16 + (H)) * 2 + 1) * 8192 + r * 128 + cc * 8); \
        pz[i] = *(const u32x4*)(zs + ((size_t)c * 128 + (ch >> 3)) * 1024 + (H) * 64 + (ch & 7) * 8); } \
      if (tid < 128) { const size_t t = (size_t)c * 128 + tid; pc0 = cum[t * 32 + (H)]; pc1 = dt[t * 32 + (H)]; pc2 = cum[t * 32 + 16 + (H)]; pc3 = dt[t * 32 + 16 + (H)]; } } while (0)
    SSD2_FETCH(gr * 8);
#pragma unroll 1
    for (int hh = 0; hh < 8; ++hh) {
      const int h = gr * 8 + hh;
      __syncthreads();
#pragma unroll
      for (int i = 0; i < 2; ++i) { const int ch = tid + 512 * i, r = ch >> 4, cc = ch & 15;
        *(u32x4*)(XT + r * 136 + cc * 8) = px[i]; *(u32x4*)(Sf + r * 136 + cc * 8) = pf[i]; *(u32x4*)(Sb + r * 136 + cc * 8) = pb[i];
        *(u32x4*)(ZT + (ch >> 3) * 72 + (ch & 7) * 8) = pz[i]; }
      if (tid < 128) { cF[tid] = pc0; dF[tid] = pc1; cB[tid] = pc2; dB[tid] = pc3; }
      __syncthreads();
      if (hh + 1 < 8) SSD2_FETCH(h + 1);
      f32x4 yacc[4];
#pragma unroll
      for (int i = 0; i < 4; ++i) yacc[i] = (f32x4){0.f, 0.f, 0.f, 0.f};
#pragma unroll 1
      for (int dir = 0; dir < 2; ++dir) {
        const float* cu = dir ? cB : cF; const float* dd = dir ? dB : dF; const bf16_t* S = dir ? Sb : Sf;
        int nn = n; asm volatile("" : "+v"(nn));
        float cl[4];
#pragma unroll
        for (int r = 0; r < 4; ++r) cl[r] = cu[16 * wid + kq * 4 + r];
        float cs8[8], ds8[8];
#pragma unroll
        for (int tc = 0; tc < 8; ++tc) { cs8[tc] = cu[16 * tc + n]; ds8[tc] = dd[16 * tc + n]; }
#pragma unroll
        for (int tc = 0; tc < 8; ++tc) { const int s_ = 16 * tc + n; const int rel = tc - wid;
          const bool full = dir ? (rel > 0) : (rel < 0);
          if (full || rel == 0) { const float cs_ = cs8[tc], ds_ = ds8[tc];
#pragma unroll
            for (int r = 0; r < 4; ++r) {
              float v = gacc[tc][r] * __expf(cl[r] - cs_) * ds_;
              if (!full) { const bool ok = dir ? (nn >= kq * 4 + r) : (nn <= kq * 4 + r); v = ok ? v : 0.f; }
              Ms[(kq * 4 + r) * 136 + s_] = f2bf(v); }
          } else {
#pragma unroll
            for (int r = 0; r < 4; ++r) Ms[(kq * 4 + r) * 136 + s_] = 0; } }
        WAVE_LDS_FENCE();
        f32x4 oacc[4];
#pragma unroll
        for (int pt = 0; pt < 4; ++pt) oacc[pt] = (f32x4){0.f, 0.f, 0.f, 0.f};
#pragma unroll
        for (int ks = 0; ks < 4; ++ks) { const bf16x8 ma = ldfrag(Ms, 136, 0, ks * 32, lane);
#pragma unroll
          for (int pt = 0; pt < 4; ++pt) { yacc[pt] = mfma16(ma, ldfrag(XT, 136, 16 * pt, ks * 32, lane), yacc[pt]);
            oacc[pt] = mfma16(ca[ks], ldfrag(S, 136, 16 * pt, ks * 32, lane), oacc[pt]); } }
        WAVE_LDS_FENCE();
#pragma unroll
        for (int r = 0; r < 4; ++r) { const float ed = __expf(cl[r]);
#pragma unroll
          for (int pt = 0; pt < 4; ++pt) yacc[pt][r] += oacc[pt][r] * ed; }
      }
      const float Dh = P.ssd_d[h];
#pragma unroll
      for (int r = 0; r < 4; ++r) { const size_t t = (size_t)c * 128 + 16 * wid + kq * 4 + r; float sq = 0.f;
#pragma unroll
        for (int pt = 0; pt < 4; ++pt) { const int col = h * 64 + 16 * pt + n;
          const int l_ = 16 * wid + kq * 4 + r, p_ = 16 * pt + n;
          const float y = (yacc[pt][r] + Dh * bf2f(XT[p_ * 136 + l_])) * bf2f(ZT[l_ * 72 + p_]);
          oc[t * 2048 + col] = f2bf(y); sq += y * y; }
        sq += __shfl_xor(sq, 1); sq += __shfl_xor(sq, 2); sq += __shfl_xor(sq, 4); sq += __shfl_xor(sq, 8);
        sqh[r] += sq; }
    }
    if (n == 0) {
#pragma unroll
      for (int r = 0; r < 4; ++r) ssq[((size_t)c * 128 + 16 * wid + kq * 4 + r) * 2 + gr] = sqh[r]; }
  }
}
#undef SSD2_FETCH
#ifndef SDG
#define SDG 2
#endif
#ifndef SDN
#define SDN 1
#endif
#ifndef PHG
#define PHG 0x1F
#endif
#ifndef GAL_SPLIT
#define GAL_SPLIT true
#endif
#ifndef GAL_GLU
#define GAL_GLU true
#endif
#ifndef GAL_RES
#define GAL_RES true
#endif
#ifndef GQA_HMAJOR
#define GQA_HMAJOR 1
#endif
#ifndef DUP
#define DUP 0
#endif
#define REP(k) for (int rep_ = 0; rep_ <= ((DUP >> (k)) & 1); ++rep_)
#define RSYNC if (rep_) __syncthreads();
#ifndef PH
#define PH 0xFFFF
#endif
__device__ __forceinline__ void gbar(unsigned* ctr, unsigned target, int tid) {
  __builtin_amdgcn_fence(__ATOMIC_RELEASE, "agent");
  asm volatile("s_waitcnt vmcnt(0) lgkmcnt(0)" ::: "memory");
  __syncthreads();
  if (tid == 0) {
    __hip_atomic_fetch_add(ctr, 1u, __ATOMIC_RELAXED, __HIP_MEMORY_SCOPE_AGENT);
    while (__hip_atomic_load(ctr, __ATOMIC_RELAXED, __HIP_MEMORY_SCOPE_AGENT) < target) __builtin_amdgcn_s_sleep(2);
  }
  __syncthreads();
  __builtin_amdgcn_fence(__ATOMIC_ACQUIRE, "agent");
  asm volatile("s_waitcnt vmcnt(0)" ::: "memory");
}
__device__ __forceinline__ Params load_params() {
#if defined(__HIP_DEVICE_COMPILE__)
  const __attribute__((address_space(4))) Params* pp = (const __attribute__((address_space(4))) Params*)__builtin_amdgcn_kernarg_segment_ptr();
  asm volatile("" : "+s"(pp));
  return *pp;
#else
  return Params{};
#endif
}
#define XB_TMO      128
#define XB_XCNT(j)  (256  + 64 * (j))
#define XB_XSUB(j)  (1280 + 64 * (j))
#define XB_XGEN(j)  (2304 + 64 * (j))
#define XB_TOP      3328
#define XB_TOPGEN   3392
#define XCD_BAR_WORDS 3456
#define XB_SPIN_CAP (1u << 18)
#define XB_LAS __attribute__((address_space(3)))
__device__ __forceinline__ unsigned xb_ld(unsigned* p)              { return __hip_atomic_load(p, __ATOMIC_RELAXED, __HIP_MEMORY_SCOPE_AGENT); }
__device__ __forceinline__ unsigned xb_add(unsigned* p, unsigned v) { return __hip_atomic_fetch_add(p, v, __ATOMIC_RELAXED, __HIP_MEMORY_SCOPE_AGENT); }
__device__ __forceinline__ unsigned xb_xcc_id() { return (unsigned)__builtin_amdgcn_s_getreg((3 << 11) | 20) & 0xFu; }
#define XB_SPIN(cond, bar) do { unsigned _sp = 0; while (cond) { __builtin_amdgcn_s_sleep(1); \
    if ((++_sp & 255u) == 0u) { if (xb_ld(&(bar)[XB_TMO])) break; if (_sp > XB_SPIN_CAP) { atomicAdd(&(bar)[XB_TMO], 1u); break; } } } } while (0)
struct XcdBarrier { unsigned* bar; unsigned x; volatile XB_LAS unsigned* st; };
__device__ __forceinline__ XcdBarrier xcd_barrier_post(unsigned* bar, volatile XB_LAS unsigned* st, int tid) {
  XcdBarrier b; b.bar = bar; b.x = xb_xcc_id(); b.st = st;
  if (tid == 0) (void)xb_add(&bar[XB_XCNT(b.x)], 1u);
  return b;
}
__device__ __forceinline__ void xcd_barrier_complete(unsigned* bar, unsigned x, unsigned& nloc, unsigned& nx, unsigned G) {
  unsigned sum, cnt, mine, sp = 0u;
  for (;;) {
    sum = 0u; cnt = 0u; mine = 0u;
#pragma unroll
    for (unsigned j = 0; j < 16; ++j) { const unsigned c = xb_ld(&bar[XB_XCNT(j)]); sum += c; cnt += (c > 0u) ? 1u : 0u; mine = (j == x) ? c : mine; }
    if (sum == G) break;
    __builtin_amdgcn_s_sleep(1);
    if ((++sp & 255u) == 0u) { if (xb_ld(&bar[XB_TMO])) break; if (sp > XB_SPIN_CAP) { atomicAdd(&bar[XB_TMO], 1u); break; } }
  }
  nloc = mine > 0u ? mine : 1u; nx = cnt > 0u ? cnt : 1u;
}
__device__ __forceinline__ void xcd_barrier(const XcdBarrier& b, int tid, unsigned G) {
  asm volatile("s_waitcnt vmcnt(0)" ::: "memory");
  __syncthreads();
  if (tid == 0) {
    unsigned* bar = b.bar;
    __builtin_amdgcn_s_waitcnt(0);
    unsigned nloc = b.st[0], nx = b.st[1];
    if (nloc == 0u) { xcd_barrier_complete(bar, b.x, nloc, nx, G); b.st[0] = nloc; b.st[1] = nx; }
    const unsigned old = xb_add(&bar[XB_XSUB(b.x)], 1u);
    const unsigned gen = old / nloc;
    if (old + 1u == (gen + 1u) * nloc) {
      __builtin_amdgcn_fence(__ATOMIC_RELEASE, "agent");
      asm volatile("s_waitcnt vmcnt(0)" ::: "memory");
      const unsigned og = xb_add(&bar[XB_TOP], 1u);
      const unsigned tg = og / nx;
      if (og + 1u == (tg + 1u) * nx) xb_add(&bar[XB_TOPGEN], 1u);
      else XB_SPIN(xb_ld(&bar[XB_TOPGEN]) == tg, bar);
      __builtin_amdgcn_fence(__ATOMIC_ACQUIRE, "agent");
      xb_add(&bar[XB_XGEN(b.x)], 1u);
      asm volatile("s_waitcnt vmcnt(0)" ::: "memory");
    } else {
      XB_SPIN(xb_ld(&bar[XB_XGEN(b.x)]) == gen, bar);
      __builtin_amdgcn_fence(__ATOMIC_ACQUIRE, "agent");
      asm volatile("s_waitcnt vmcnt(0)" ::: "memory");
    }
  }
  __syncthreads();
}
constexpr int LDS_BYTES = 147456;
__global__ __launch_bounds__(512, 2) void mega_fwd(Params Parg) {
  extern __shared__ __attribute__((aligned(16))) unsigned char shm[];
  cg::grid_group grid = cg::this_grid();
  const int G = gridDim.x, bid = blockIdx.x, ngw = G * 8;
  const int wid_s = __builtin_amdgcn_readfirstlane((int)threadIdx.x >> 6);
#define IDS unsigned z_ = 0u; asm volatile("" : "+v"(z_)); int tid_ = wid_s * 64 + (int)__builtin_amdgcn_mbcnt_hi(~0u, __builtin_amdgcn_mbcnt_lo(~0u, z_)); asm volatile("" : "+v"(tid_)); const int tid = tid_, wid = __builtin_amdgcn_readfirstlane(tid >> 6), lane = tid & 63, gw = bid * 8 + wid; (void)lane; (void)gw; (void)wid; \
  const Params P = load_params(); unsigned char* ws = P.ws; (void)ws; \
  const float* mod0 = (const float*)(ws + O_MOD); const float* mod1 = mod0 + 6144; (void)mod0; (void)mod1;
  PG8_LAS unsigned char* glds = (PG8_LAS unsigned char*)shm;
  unsigned* xbar = (unsigned*)(Parg.ws + O_BAR);
  volatile XB_LAS unsigned* xst = (volatile XB_LAS unsigned*)(shm + 147440);
  if (threadIdx.x == 0) { xst[0] = 0u; xst[1] = 0u; }
  if (bid == 0) { for (int i = threadIdx.x; i < XCD_BAR_WORDS; i += 512) xbar[i] = 0u; }
  XcdBarrier xbs; xbs.bar = xbar; xbs.x = 0u; xbs.st = xst;
#define GBAR { IDS; xcd_barrier(xbs, tid, (unsigned)G); }
  REP(0) { RSYNC if (PH & (1 << 0)) {  { IDS; p0_phase(P, shm, bid, G, tid, wid, lane); } } }
  grid.sync();
  { IDS; xbs = xcd_barrier_post(xbar, xst, tid); }
  REP(1) { RSYNC if (PH & (1 << 1)) {  { IDS; norm_mod_phase(P.x, P.e_norm_g, mod0, (bf16_t*)(ws + O_H), gw, ngw, lane); } } }
  { IDS; w_in_o_phase(P, shm, gw, ngw, wid, lane); }
  GBAR
  if (DUP & (1 << 14)) { for (int xb = 0; xb < 10; ++xb) GBAR }
  REP(2) if ((PH & (1 << 5)) && (PHG & (1 << 0))) { IDS; pg8::Gemm g{(const bf16_t*)(ws + O_H), (const bf16_t*)(ws + O_WT_IN_E), L, 4608, 2048}; pg8::StaticOrder S; S.init(L, 4608, G, bid);
    pg8::EpiSplit E{ws, 0}; pg8::gemm_phase<pg8::EpiSplit, pg8::StaticOrder, GAL_SPLIT, true>(glds, g, S, E, tid); }
  GBAR
  REP(3) { RSYNC if (PH & (1 << 2)) {  { IDS; kprep_gqa_phase(P, gw, ngw, lane); } }
  if (PH & (1 << 3)) {  { IDS; s5_phase<false>(P, shm, gw, ngw, wid, lane); } } }
  GBAR
  { IDS; s5_carry_phase(P, bid, G, wid, lane); }
  GBAR
  REP(4) { RSYNC if (PH & (1 << 4)) {  { IDS; s5_phase<true>(P, shm, gw, ngw, wid, lane); } } }
  GBAR
  REP(5) if (PH & (1 << 6)) for (int u = bid; u < 512; u += G) {
    IDS; const int h = GQA_HMAJOR ? (u >> 6) : (u & 7), qb = GQA_HMAJOR ? (u & 63) : (u >> 3), kvh = h >> 2; const size_t tok0 = (size_t)qb * 256;
    __syncthreads();
    attn_body<0, 1024, 256, 2048, SDG>((const bf16_t*)(ws + O_RA) + tok0 * 1024 + h * 128, (const bf16_t*)(ws + O_KN) + kvh * 128, (const bf16_t*)(ws + O_V0) + kvh * 128,
                                  (const bf16_t*)(ws + O_RA + SZ_LK) + tok0 * 1024 + h * 128, (bf16_t*)(ws + O_OA) + tok0 * 2048 + h * 128, P.e_q_norm, L / 64, (int)tok0, 0, 0, (char*)shm, tid);
  }
  __syncthreads();
  REP(6) if ((PH & (1 << 5)) && (PHG & (1 << 1))) { IDS; pg8::Gemm g{(const bf16_t*)(ws + O_Y), (const bf16_t*)(ws + O_WT_GLU), L, 2048, 1024}; pg8::StaticOrder S; S.init(L, 2048, G, bid);
    pg8::EpiGlu E{ws, P.s5_b_glu}; pg8::gemm_phase<pg8::EpiGlu, pg8::StaticOrder, GAL_GLU, true>(glds, g, S, E, tid); }
  GBAR
  REP(7) if ((PH & (1 << 5)) && (PHG & (1 << 2))) { IDS; pg8::Gemm g{(const bf16_t*)(ws + O_OA), (const bf16_t*)(ws + O_WT_OUT_E), L, 2048, 2048}; pg8::StaticOrder S; S.init(L, 2048, G, bid);
    pg8::EpiResX E{P.x, P.out, mod0 + 4096, (bf16_t*)(ws + O_H), (float*)(ws + O_SSQ1)}; pg8::gemm_phase<pg8::EpiResX, pg8::StaticOrder, GAL_RES, true>(glds, g, S, E, tid); }
  GBAR
  REP(9) if ((PH & (1 << 5)) && (PHG & (1 << 3))) { IDS; pg8::Gemm g{(const bf16_t*)(ws + O_H), (const bf16_t*)(ws + O_WT_IN_O), L, 6912, 2048}; pg8::StaticOrder S; S.init(L, 6912, G, bid);
    pg8::EpiSplit E{ws, 1}; pg8::gemm_phase<pg8::EpiSplit, pg8::StaticOrder, GAL_SPLIT, true>(glds, g, S, E, tid); }
  GBAR
  REP(10) { RSYNC if (PH & (1 << 8)) {  { IDS; prep1_phase(P, shm, gw, ngw, wid, lane, rep_ == 0); } } }
  GBAR
  REP(11) if (PH & (1 << 7)) for (int u = bid; u < 512; u += G) {
    IDS; const int h = u >> 6, rg = u & 63, r0 = rg * 4, t0 = min(max(r0 - 4, 0), 244); const size_t tok0 = (size_t)rg * 256;
    __syncthreads();
    { if (tid < 465) ((float*)(shm + SHM_ATTN))[64 + tid] = P.na_rpb[h * 465 + tid] * (1.f / SCALE); }
    attn_body<1, 1024, 1024, 2048, SDN>((const bf16_t*)(ws + O_RA) + tok0 * 1024 + h * 128, (const bf16_t*)(ws + O_RA + SZ_LK) + (size_t)t0 * 64 * 1024 + h * 128,
                                   (const bf16_t*)(ws + O_RA + 2 * SZ_LK) + (size_t)t0 * 64 * 1024 + h * 128, (const bf16_t*)(ws + O_RA + 3 * SZ_LK) + tok0 * 1024 + h * 128,
                                   (bf16_t*)(ws + O_OA) + tok0 * 2048 + 1024 + h * 128, P.o_q_norm, 12, (int)tok0, r0, t0, (char*)shm, tid);
  }
  REP(12) { RSYNC if (PH & (1 << 10)) {  { IDS; ssd1_phase(P, shm, bid, G, tid, wid, lane); } } }
  GBAR
  if (PH & (1 << 11)) {  { IDS; ssd_carry_phase(P, bid, G, tid); } }
  GBAR
  REP(13) { RSYNC if (PH & (1 << 12)) {  { IDS; ssd2_phase(P, shm, bid, G, tid, wid, lane); } } }
  GBAR
  if ((PH & (1 << 5)) && (PHG & (1 << 4))) { IDS; pg8::Gemm g{(const bf16_t*)(ws + O_OA), (const bf16_t*)(ws + O_WT_OUT_O), L, 2048, 2048}; pg8::StaticOrder S; S.init(L, 2048, G, bid);
    pg8::EpiResScale E{P.out, P.out, mod1 + 4096, (const float*)(ws + O_SSQ)}; pg8::gemm_phase<pg8::EpiResScale, pg8::StaticOrder, GAL_RES, true>(glds, g, S, E, tid); }
}

extern "C" void kernel_launch(void* const* d_in, const int* in_sizes, int n_in, void* d_out, int out_size, void* d_ws, size_t ws_size, hipStream_t stream) {
  static int grid_blocks = 0;
  if (grid_blocks == 0) {
    if (n_in != 33 || out_size != L * DM || ws_size < WS_END) { fprintf(stderr, "kernel_launch: unexpected shapes: n_in %d out %d ws %zu (need %zu)\n", n_in, out_size, ws_size, (size_t)WS_END); grid_blocks = -1; return; }
    int dev = 0, cus = 0, per_cu = 0;
    if (hipGetDevice(&dev) != hipSuccess || hipDeviceGetAttribute(&cus, hipDeviceAttributeMultiprocessorCount, dev) != hipSuccess) { grid_blocks = -1; return; }
    if (hipFuncSetAttribute((const void*)mega_fwd, hipFuncAttributeMaxDynamicSharedMemorySize, LDS_BYTES) != hipSuccess) { fprintf(stderr, "kernel_launch: hipFuncSetAttribute failed\n"); grid_blocks = -1; return; }
    if (hipOccupancyMaxActiveBlocksPerMultiprocessor(&per_cu, (const void*)mega_fwd, 512, LDS_BYTES) != hipSuccess || per_cu < 1) { fprintf(stderr, "kernel_launch: occupancy query says %d\n", per_cu); per_cu = 1; }
    (void)hipGetLastError();
    grid_blocks = cus;
  }
  if (grid_blocks < 0) return;
  Params p{};
  const float** pf = (const float**)&p;
  for (int i = 0; i < 33; ++i) pf[i] = (const float*)d_in[i];
  p.out = (float*)d_out; p.ws = (unsigned char*)d_ws;
  void* args[] = {&p};
  hipError_t e = hipLaunchCooperativeKernel((const void*)mega_fwd, dim3(grid_blocks), dim3(512), args, LDS_BYTES, stream);
  if (e != hipSuccess) fprintf(stderr, "cooperative launch failed: %s (grid %d)\n", hipGetErrorString(e), grid_blocks);
}
```

```cpp
#include <hip/hip_runtime.h>
#include <hip/hip_cooperative_groups.h>
#include <cstdio>
#include <cstdint>
namespace cg = cooperative_groups;

typedef unsigned short bf16_t;
using bf16x8 = __attribute__((ext_vector_type(8))) short;
using s16x4  = __attribute__((ext_vector_type(4))) short;
using f32x16 = __attribute__((ext_vector_type(16))) float;
using f32x8  = __attribute__((ext_vector_type(8))) float;
using f32x4  = __attribute__((ext_vector_type(4))) float;
using u32x4  = __attribute__((ext_vector_type(4))) unsigned;
using u32x2  = __attribute__((ext_vector_type(2))) unsigned;

constexpr int L = 16384, DM = 2048, NCH = 128;
constexpr float SCALE = 0.088388347648318440f;
constexpr float THR = 8.f;
constexpr float EPS = 1e-6f;

constexpr size_t SZ_LK  = (size_t)L * 1024 * 2;
constexpr size_t O_WT_IN_E = 0;
constexpr size_t O_WT_GLU  = O_WT_IN_E + (size_t)4608 * 2048 * 2;
constexpr size_t O_WT_IN_O = O_WT_GLU + (size_t)2048 * 1024 * 2;
constexpr size_t O_XBCT    = 0;
constexpr size_t O_WT_OUT_E = O_WT_IN_O + (size_t)6912 * 2048 * 2;
constexpr size_t O_WT_OUT_O = O_WT_OUT_E + (size_t)2048 * 2048 * 2;
constexpr size_t O_MOD  = O_WT_OUT_O + (size_t)2048 * 2048 * 2;
constexpr size_t O_BBAR = O_MOD + 2 * 6144 * 4;
constexpr size_t O_CMAT = O_BBAR + 2 * 64 * 128 * 16 * 2;
constexpr size_t O_AB   = O_CMAT + 2 * 64 * 16 * 128 * 2;
constexpr size_t O_H    = O_AB + 2 * 64 * 64 * 2 * 4;
constexpr size_t O_RA   = O_H + (size_t)L * 2048 * 2;
constexpr size_t O_RB   = O_RA + 4 * SZ_LK;
constexpr size_t O_KR   = O_RB;
constexpr size_t O_KN   = O_KR + (size_t)L * 256 * 2;
constexpr size_t O_V0   = O_KN + (size_t)L * 256 * 2;
constexpr size_t O_S5E  = O_V0 + (size_t)L * 256 * 2;
constexpr size_t O_ZS   = O_RB;
constexpr size_t O_XBCR = O_ZS + SZ_LK;
constexpr size_t O_XBCC = O_XBCR + (size_t)L * 1536 * 2;
constexpr size_t O_DTR  = O_XBCC + (size_t)L * 1536 * 2;
constexpr size_t O_DT   = O_DTR + (size_t)L * 32 * 4;
constexpr size_t O_CUM  = O_DT + (size_t)L * 32 * 4;
constexpr size_t O_TOT  = O_CUM + (size_t)L * 32 * 4;
constexpr size_t O_SSQ  = O_TOT + 128 * 32 * 4;
constexpr size_t O_RB_END = O_SSQ + (size_t)L * 16 * 4;
constexpr size_t O_OA   = O_RB_END;
constexpr size_t O_Y    = O_OA + (size_t)L * 2048 * 2;
constexpr size_t O_BAR  = O_Y + SZ_LK;
constexpr size_t O_SSQ1 = O_BAR + 16384;
constexpr size_t O_SWO  = O_SSQ1 + (size_t)L * 4;
constexpr size_t WS_END = O_SWO + 32768;
static_assert(O_XBCT + (size_t)1536 * L * 2 <= O_WT_OUT_E, "xbcT overlay");
static_assert(O_S5E + (size_t)128 * 64 * 2 * 128 * 4 <= O_RB_END, "layer-0 RB");

struct Params {
  const float *x, *c, *e_norm_g, *e_ada_w, *e_ada_b, *e_w_in, *e_q_norm, *e_k_norm, *s5_lam_re, *s5_lam_im, *s5_log_step, *s5_b_re, *s5_b_im,
              *s5_c_re, *s5_c_im, *s5_d, *s5_w_glu, *s5_b_glu, *e_w_out, *o_norm_g, *o_ada_w, *o_ada_b, *o_w_in, *o_q_norm, *o_k_norm, *na_rpb,
              *ssd_conv_w, *ssd_conv_b, *ssd_dt_bias, *ssd_a_log, *ssd_d, *ssd_norm_w, *o_w_out;
  float* out; unsigned char* ws;
};

#define WAVE_LDS_FENCE() asm volatile("s_waitcnt lgkmcnt(0)" ::: "memory")
__device__ __forceinline__ float bf2f(bf16_t b) { return __uint_as_float(((unsigned)b) << 16); }
__device__ __forceinline__ bf16_t f2bf(float f) { unsigned u = __float_as_uint(f); u += 0x7FFFu + ((u >> 16) & 1u); return (bf16_t)(u >> 16); }
__device__ __forceinline__ unsigned pk2(float lo, float hi) { unsigned r; asm volatile("v_cvt_pk_bf16_f32 %0, %1, %2" : "=v"(r) : "v"(lo), "v"(hi)); return r; }
__device__ __forceinline__ float lo2f(unsigned w) { return __uint_as_float(w << 16); }
__device__ __forceinline__ float hi2f(unsigned w) { return __uint_as_float(w & 0xffff0000u); }
__device__ __forceinline__ float silu_f(float v) { return v * __builtin_amdgcn_rcpf(1.f + __expf(-v)); }
__device__ __forceinline__ float sigmoid_f(float v) { return __builtin_amdgcn_rcpf(1.f + __expf(-v)); }
__device__ __forceinline__ float wave_sum(float v) {
#pragma unroll
  for (int o = 1; o < 64; o <<= 1) v += __shfl_xor(v, o);
  return v;
}
__device__ __forceinline__ void sincos_rev(float ang, float& s, float& c) {
  float rev = ang * 0.15915494309189535f; rev -= floorf(rev);
  s = __builtin_amdgcn_sinf(rev); c = __builtin_amdgcn_cosf(rev);
}
__device__ __forceinline__ f32x4 mfma16(bf16x8 a, bf16x8 b, f32x4 c) { return __builtin_amdgcn_mfma_f32_16x16x32_bf16(a, b, c, 0, 0, 0); }
__device__ __forceinline__ bf16x8 ldfrag(const bf16_t* base, int ld, int r0, int k0, int lane) {
  return *reinterpret_cast<const bf16x8*>(base + (r0 + (lane & 15)) * ld + k0 + (lane >> 4) * 8);
}
namespace pg8 {
#define PG8_LAS __attribute__((address_space(3)))
typedef unsigned short bf16_t;
typedef short bf16x8 __attribute__((ext_vector_type(8)));
typedef float f32x4 __attribute__((ext_vector_type(4)));
typedef unsigned u32x4 __attribute__((ext_vector_type(4)));
constexpr int BM = 256, BK = 64, HALF = 128, HTB = HALF * BK * 2  , STAGE_BYTES = 8 * HTB, NXCD = 8, WGM = 8;

__host__ __device__ __forceinline__ int lds_byte(int r, int c) { const int st = (r >> 4) * 2 + (c >> 5), rr = r & 15, cc = c & 31, ob = rr * 64 + cc * 2; return st * 1024 + (ob ^ (((ob >> 9) & 1) << 5)); }
__host__ __device__ __forceinline__ void stage_rc(int b, int& R, int& C) { const int st = b / 1024, sb = b % 1024, swz = sb ^ (((sb >> 9) & 1) << 5); R = (st >> 1) * 16 + swz / 64; C = (st & 1) * 32 + (swz % 64) / 2; }
__host__ __device__ __forceinline__ int perm32(int rho) { const int n = rho >> 4, i = rho & 15; return 8 * (i >> 2) + 4 * n + (i & 3); }

struct Unit { int pm, pn; };
struct Gemm { const bf16_t* A; const bf16_t* Bt; int M, N, K; };

struct StaticOrder {
    int nM, nN, nwg, G, c;
    __host__ __device__ void init(int M, int N, int G_, int c_) { nM = M / BM; nN = N / BM; nwg = nM * nN; G = G_; c = c_; }
    __host__ __device__ bool next(int i, Unit& u) const {
        const long L = (long)i * G + c; if (L >= nwg) return false;
        int wgid = (int)L; { const int q = nwg / NXCD, r = nwg % NXCD, xcd = wgid % NXCD, off = wgid / NXCD; wgid = (xcd < r ? xcd * (q + 1) : r * (q + 1) + (xcd - r) * q) + off; }
        const int nig = WGM * nN, gid = wgid / nig, fm = gid * WGM, gsz = (nM - fm) < WGM ? (nM - fm) : WGM;
        u.pm = fm + ((wgid % nig) % gsz); u.pn = (wgid % nig) / gsz; return true;
    }
    __device__ __forceinline__ void a_ready(const Unit&) const {}
    __device__ __forceinline__ void done(const Unit&) const {}
};
__device__ __forceinline__ unsigned cvt_pk_bf16(float lo, float hi) { unsigned r; asm volatile("v_cvt_pk_bf16_f32 %0, %1, %2" : "=v"(r) : "v"(lo), "v"(hi)); return r; }
template <class Epi, class Sched, bool ALIGN_EPI = false, bool SP2 = false>
__device__ __forceinline__ void gemm_phase(PG8_LAS unsigned char* lds, const Gemm g, const Sched& S, const Epi& E, const int tid) {
    const int wid = __builtin_amdgcn_readfirstlane(tid >> 6), lane = tid & 63, wr = wid >> 2, wc = wid & 3, fr = lane & 15, fq = lane >> 4;
    const int K = g.K, nt = K / BK;
    unsigned voffA[2], voffB[2];
#pragma unroll
    for (int i = 0; i < 2; ++i) { int R, C; stage_rc(tid * 16 + i * 8192, R, C); const int Rb = Epi::PERM ? ((R & ~31) + perm32(R & 31)) : R;
        voffA[i] = (unsigned)(R * K + C) * 2u; voffB[i] = (unsigned)(Rb * K + C) * 2u; }
    const size_t kstep = (size_t)(BK * 2);
    const size_t hstep = (size_t)HALF * K * 2;
    const size_t tstep = 2 * hstep;
    const unsigned ldsw = (unsigned)wid * 1024u;
    const int aoff = lds_byte(wr * 64 + fr, fq * 8), boff = lds_byte(wc * 32 + fr, fq * 8);
#define PG8_SA(b, h) (((b) * 2 + (h)) * HTB)
#define PG8_SB(b, h) ((4 + (b) * 2 + (h)) * HTB)
#define PG8_STAGE(bufoff, gbase, voff) do { _Pragma("unroll") for (int _i = 0; _i < 2; ++_i) \
        __builtin_amdgcn_global_load_lds((const unsigned*)((const char*)(gbase) + (voff)[_i]), (PG8_LAS unsigned*)(lds + (bufoff) + ldsw + _i * 8192), 16, 0, 0); } while (0)
#define PG8_LDA(dst, b, h) do { _Pragma("unroll") for (int m = 0; m < 4; ++m) _Pragma("unroll") for (int k = 0; k < 2; ++k) dst[m][k] = *(const PG8_LAS bf16x8*)(lds + PG8_SA(b, h) + aoff + m * 2048 + k * 1024); } while (0)
#define PG8_LDB(dst, b, h) do { _Pragma("unroll") for (int n = 0; n < 2; ++n) _Pragma("unroll") for (int k = 0; k < 2; ++k) dst[n][k] = *(const PG8_LAS bf16x8*)(lds + PG8_SB(b, h) + boff + n * 2048 + k * 1024); } while (0)
#define PG8_MMA(ai, bj, At, Bt) do { __builtin_amdgcn_s_setprio(1); _Pragma("unroll") for (int m = 0; m < 4; ++m) _Pragma("unroll") for (int n = 0; n < 2; ++n) _Pragma("unroll") for (int k = 0; k < 2; ++k) \
        acc[ai][bj][m][n] = __builtin_amdgcn_mfma_f32_16x16x32_bf16(Bt[n][k], At[m][k], acc[ai][bj][m][n], 0, 0, 0); __builtin_amdgcn_s_setprio(0); } while (0)
#define PG8_WAIT_V(n) asm volatile("s_waitcnt vmcnt(" #n ")" ::: "memory")
#define PG8_WAIT_L(n) asm volatile("s_waitcnt lgkmcnt(" #n ")" ::: "memory")
#define PG8_BAR __builtin_amdgcn_s_barrier()
#define PG8_SCHED __builtin_amdgcn_sched_barrier(0)
    Unit cur, nxt; int ui = 0;
    if (!S.next(0, cur)) return;
    f32x4 acc[2][2][4][2];
#pragma unroll
    for (int a = 0; a < 2; ++a)
#pragma unroll
        for (int b = 0; b < 2; ++b)
#pragma unroll
            for (int m = 0; m < 4; ++m)
#pragma unroll
                for (int n = 0; n < 2; ++n) acc[a][b][m][n] = (f32x4){0.f, 0.f, 0.f, 0.f};
    bf16x8 At[4][2], B0[2][2], B1[2][2];
    const char* cA = (const char*)g.A + (size_t)cur.pm * tstep; const char* cB = (const char*)g.Bt + (size_t)cur.pn * tstep;
    S.a_ready(cur);
    if constexpr (SP2) {
        PG8_STAGE(PG8_SB(0, 0), cB, voffB); PG8_STAGE(PG8_SB(0, 1), cB + hstep, voffB); PG8_STAGE(PG8_SA(0, 0), cA, voffA); PG8_STAGE(PG8_SA(0, 1), cA + hstep, voffA);
        if (wr == 1) PG8_BAR;
        PG8_WAIT_V(2); PG8_BAR;
        PG8_STAGE(PG8_SB(1, 0), cB + kstep, voffB); PG8_STAGE(PG8_SA(1, 0), cA + kstep, voffA); PG8_STAGE(PG8_SB(1, 1), cB + hstep + kstep, voffB);
        PG8_WAIT_V(6); PG8_BAR;
    } else {
        PG8_STAGE(PG8_SB(0, 0), cB, voffB); PG8_STAGE(PG8_SA(0, 0), cA, voffA); PG8_STAGE(PG8_SB(0, 1), cB + hstep, voffB); PG8_STAGE(PG8_SA(0, 1), cA + hstep, voffA);
        if (wr == 1) PG8_BAR;
        PG8_WAIT_V(4); PG8_BAR;
        PG8_STAGE(PG8_SB(1, 0), cB + kstep, voffB); PG8_STAGE(PG8_SA(1, 0), cA + kstep, voffA); PG8_STAGE(PG8_SB(1, 1), cB + hstep + kstep, voffB);
        PG8_WAIT_V(6); PG8_BAR;
    }
    for (;;) {
        const bool has_next = S.next(ui + 1, nxt);
        const char* nA = has_next ? (const char*)g.A + (size_t)nxt.pm * tstep : cA; const char* nB = has_next ? (const char*)g.Bt + (size_t)nxt.pn * tstep : cB;
        for (int t = 0; t < nt; t += 2) {
            const bool last = (t == nt - 2);
            const char* a1 = cA + (size_t)(t + 1) * kstep;
            const char* a2 = last ? nA : cA + (size_t)(t + 2) * kstep; const char* b2 = last ? nB : cB + (size_t)(t + 2) * kstep;
            const char* a3 = a2 + kstep; const char* b3 = b2 + kstep;
            if (last && has_next) S.a_ready(nxt);
            if constexpr (Epi::MIDSCALE) { if (t == nt / 2) E.midscale(acc, cur, wr, fr); }
            if constexpr (SP2) {
            PG8_LDB(B0, 0, 0); PG8_LDB(B1, 0, 1); PG8_SCHED; PG8_LDA(At, 0, 0); PG8_STAGE(PG8_SA(1, 1), a1 + hstep, voffA);
            PG8_WAIT_V(8); PG8_WAIT_L(0); PG8_BAR; PG8_MMA(0, 0, At, B0); PG8_MMA(0, 1, At, B1); PG8_BAR; PG8_SCHED;
            PG8_LDA(At, 0, 1); PG8_STAGE(PG8_SB(0, 0), b2, voffB); PG8_STAGE(PG8_SB(0, 1), b2 + hstep, voffB); PG8_STAGE(PG8_SA(0, 0), a2, voffA);
            PG8_WAIT_V(8); PG8_WAIT_L(0); PG8_BAR; PG8_MMA(1, 0, At, B0); PG8_MMA(1, 1, At, B1); PG8_BAR; PG8_SCHED;
            PG8_LDB(B0, 1, 0); PG8_LDB(B1, 1, 1); PG8_SCHED; PG8_LDA(At, 1, 0); PG8_STAGE(PG8_SA(0, 1), a2 + hstep, voffA);
            PG8_WAIT_V(8); PG8_WAIT_L(0); PG8_BAR; PG8_MMA(0, 0, At, B0); PG8_MMA(0, 1, At, B1); PG8_BAR; PG8_SCHED;
            PG8_LDA(At, 1, 1); PG8_STAGE(PG8_SB(1, 0), b3, voffB); PG8_STAGE(PG8_SB(1, 1), b3 + hstep, voffB); PG8_STAGE(PG8_SA(1, 0), a3, voffA);
            PG8_WAIT_V(8); PG8_WAIT_L(0); PG8_BAR; PG8_MMA(1, 0, At, B0); PG8_MMA(1, 1, At, B1); PG8_BAR; PG8_SCHED;
            } else {
            PG8_LDB(B0, 0, 0); PG8_SCHED; PG8_LDA(At, 0, 0); PG8_STAGE(PG8_SA(1, 1), a1 + hstep, voffA);
            PG8_WAIT_L(8); PG8_BAR; PG8_WAIT_L(0); PG8_MMA(0, 0, At, B0); PG8_BAR; PG8_SCHED;
            PG8_LDB(B1, 0, 1); PG8_STAGE(PG8_SB(0, 0), b2, voffB);
            PG8_BAR; PG8_WAIT_L(0); PG8_MMA(0, 1, At, B1); PG8_BAR;
            PG8_LDA(At, 0, 1); PG8_STAGE(PG8_SA(0, 0), a2, voffA);
            PG8_BAR; PG8_WAIT_L(0); PG8_MMA(1, 0, At, B0); PG8_BAR; PG8_SCHED;
            PG8_STAGE(PG8_SB(0, 1), b2 + hstep, voffB);
            PG8_WAIT_V(6); PG8_BAR; PG8_MMA(1, 1, At, B1); PG8_BAR;
            PG8_LDB(B0, 1, 0); PG8_SCHED; PG8_LDA(At, 1, 0); PG8_STAGE(PG8_SA(0, 1), a2 + hstep, voffA);
            PG8_WAIT_L(8); PG8_BAR; PG8_WAIT_L(0); PG8_MMA(0, 0, At, B0); PG8_BAR; PG8_SCHED;
            PG8_LDB(B1, 1, 1); PG8_STAGE(PG8_SB(1, 0), b3, voffB);
            PG8_BAR; PG8_WAIT_L(0); PG8_MMA(0, 1, At, B1); PG8_BAR;
            PG8_LDA(At, 1, 1); PG8_STAGE(PG8_SA(1, 0), a3, voffA);
            PG8_BAR; PG8_WAIT_L(0); PG8_MMA(1, 0, At, B0); PG8_BAR; PG8_SCHED;
            PG8_STAGE(PG8_SB(1, 1), b3 + hstep, voffB);
            PG8_WAIT_V(6); PG8_BAR; PG8_MMA(1, 1, At, B1); PG8_BAR;
            }
        }
        if constexpr (ALIGN_EPI) { if (wr == 0) PG8_BAR; }
        if constexpr (!Epi::AFTER_DRAIN) { E(acc, cur, wr, wc, fr, fq); S.done(cur); }
        if (!has_next) break;
#pragma unroll
        for (int a = 0; a < 2; ++a)
#pragma unroll
            for (int b = 0; b < 2; ++b)
#pragma unroll
                for (int m = 0; m < 4; ++m)
#pragma unroll
                    for (int n = 0; n < 2; ++n) acc[a][b][m][n] = (f32x4){0.f, 0.f, 0.f, 0.f};
        cur = nxt; cA = nA; cB = nB; ++ui;
        if constexpr (ALIGN_EPI) { if (wr == 1) PG8_BAR; }
    }
    PG8_WAIT_V(0);
    if constexpr (!ALIGN_EPI) { if (wr == 0) PG8_BAR; }
    PG8_BAR;
    if constexpr (Epi::AFTER_DRAIN) { E.fused(acc, cur, wr, wc, fr, fq, lds, wid, lane); S.done(cur); }
#undef PG8_SA
#undef PG8_SB
#undef PG8_STAGE
#undef PG8_LDA
#undef PG8_LDB
#undef PG8_MMA
#undef PG8_WAIT_V
#undef PG8_WAIT_L
#undef PG8_BAR
#undef PG8_SCHED
}
}
namespace pg8 {
struct EpiSplit {
  static constexpr bool PERM = true, AFTER_DRAIN = false, MIDSCALE = false;
  unsigned char* ws; int layer;
  __device__ __forceinline__ void operator()(const f32x4 (&acc)[2][2][4][2], const Unit& u, int wr, int wc, int fr_, int fq_) const {
    int fr = fr_, fq = fq_; asm volatile("" : "+v"(fr), "+v"(fq));
    unsigned char* ws = this->ws; asm volatile("" : "+s"(ws));
    float rs[2][4]; f32x4 sw[2][2];
#pragma unroll
    for (int ai = 0; ai < 2; ++ai)
#pragma unroll
      for (int m = 0; m < 4; ++m) rs[ai][m] = 1.f;
#pragma unroll
    for (int bj = 0; bj < 2; ++bj)
#pragma unroll
      for (int n = 0; n < 2; ++n) sw[bj][n] = (f32x4){0.f, 0.f, 0.f, 0.f};
    if (layer == 1) { const float* sq = (const float*)(ws + O_SSQ1); const float* sWp = (const float*)(ws + O_SWO);
#pragma unroll
      for (int ai = 0; ai < 2; ++ai)
#pragma unroll
        for (int m = 0; m < 4; ++m) rs[ai][m] = rsqrtf(sq[u.pm * BM + ai * HALF + wr * 64 + m * 16 + fr] * (1.f / DM) + EPS);
#pragma unroll
      for (int bj = 0; bj < 2; ++bj)
#pragma unroll
        for (int n = 0; n < 2; ++n) sw[bj][n] = *(const f32x4*)(sWp + u.pn * BM + bj * HALF + wc * 32 + 8 * fq + 4 * n); }
    bf16_t* dst; int ld, c0, act = 0; const int pn = u.pn;
    if (layer == 0) {
      if (pn < 4)       { dst = (bf16_t*)(ws + O_RA);             ld = 1024; c0 = pn * 256; }
      else if (pn == 4) { dst = (bf16_t*)(ws + O_KR);             ld = 256;  c0 = 0; }
      else if (pn == 5) { dst = (bf16_t*)(ws + O_V0);             ld = 256;  c0 = 0; }
      else if (pn < 10) { dst = (bf16_t*)(ws + O_RA + SZ_LK);     ld = 1024; c0 = (pn - 6) * 256; act = 1; }
      else if (pn < 14) { dst = (bf16_t*)(ws + O_RA + 2 * SZ_LK); ld = 1024; c0 = (pn - 10) * 256; }
      else              { dst = (bf16_t*)(ws + O_RA + 3 * SZ_LK); ld = 1024; c0 = (pn - 14) * 256; act = 1; }
    } else {
      if (pn < 12)      { dst = (bf16_t*)(ws + O_RA + (size_t)(pn >> 2) * SZ_LK); ld = 1024; c0 = (pn & 3) * 256; }
      else if (pn < 16) { dst = (bf16_t*)(ws + O_RA + 3 * SZ_LK); ld = 1024; c0 = (pn - 12) * 256; act = 1; }
      else if (pn < 20) { dst = (bf16_t*)(ws + O_ZS);             ld = 1024; c0 = (pn - 16) * 256; act = 1; }
      else if (pn < 26) { dst = (bf16_t*)(ws + O_XBCR);           ld = 1536; c0 = (pn - 20) * 256; }
      else {
        if (wc == 0) {
          float* d = (float*)(ws + O_DTR);
#pragma unroll
          for (int ai = 0; ai < 2; ++ai)
#pragma unroll
            for (int m = 0; m < 4; ++m) { const int row = u.pm * BM + ai * HALF + wr * 64 + m * 16 + fr;
              *(f32x4*)(d + (size_t)row * 32 + 8 * fq)     = acc[ai][0][m][0] * rs[ai][m] + sw[0][0];
              *(f32x4*)(d + (size_t)row * 32 + 8 * fq + 4) = acc[ai][0][m][1] * rs[ai][m] + sw[0][1]; }
        }
        return;
      }
    }
    const int row0 = u.pm * BM + wr * 64 + fr, col0 = c0 + wc * 32 + 8 * fq;
#pragma unroll
    for (int ai = 0; ai < 2; ++ai)
#pragma unroll
      for (int m = 0; m < 4; ++m) { bf16_t* rowp = dst + (size_t)(row0 + ai * HALF + m * 16) * ld + col0;
#pragma unroll
        for (int bj = 0; bj < 2; ++bj) { f32x4 v0 = acc[ai][bj][m][0] * rs[ai][m] + sw[bj][0], v1 = acc[ai][bj][m][1] * rs[ai][m] + sw[bj][1];
          if (act) {
#pragma unroll
            for (int e = 0; e < 4; ++e) { v0[e] = silu_f(v0[e]); v1[e] = silu_f(v1[e]); } }
          u32x4 o; o[0] = pk2(v0[0], v0[1]); o[1] = pk2(v0[2], v0[3]); o[2] = pk2(v1[0], v1[1]); o[3] = pk2(v1[2], v1[3]);
          *(u32x4*)(rowp + bj * HALF) = o; } }
  }
};
struct EpiGlu {
  static constexpr bool PERM = true, AFTER_DRAIN = false, MIDSCALE = false;
  unsigned char* ws; const float* bias;
  __device__ __forceinline__ void operator()(const f32x4 (&acc)[2][2][4][2], const Unit& u, int wr, int wc, int fr_, int fq_) const {
    int fr = fr_, fq = fq_; asm volatile("" : "+v"(fr), "+v"(fq));
    unsigned char* ws = this->ws; const float* bias = this->bias; asm volatile("" : "+s"(ws), "+s"(bias));
    const bf16_t* gb = (const bf16_t*)(ws + O_RA + 3 * SZ_LK); bf16_t* oa = (bf16_t*)(ws + O_OA);
    const int row0 = u.pm * BM + wr * 64 + fr, col = u.pn * 128 + wc * 32 + 8 * fq;
    const f32x4 bv0 = *(const f32x4*)(bias + col), bv1 = *(const f32x4*)(bias + col + 4), bg0 = *(const f32x4*)(bias + 1024 + col), bg1 = *(const f32x4*)(bias + 1024 + col + 4);
#pragma unroll
    for (int ai = 0; ai < 2; ++ai)
#pragma unroll
      for (int m = 0; m < 4; ++m) { const size_t row = (size_t)(row0 + ai * HALF + m * 16);
        const u32x4 g = *(const u32x4*)(gb + row * 1024 + col);
        f32x4 a0 = acc[ai][0][m][0] + bv0, a1 = acc[ai][0][m][1] + bv1, t0 = acc[ai][1][m][0] + bg0, t1 = acc[ai][1][m][1] + bg1;
        float r[8];
#pragma unroll
        for (int e = 0; e < 4; ++e) { r[e] = a0[e] * sigmoid_f(t0[e]); r[4 + e] = a1[e] * sigmoid_f(t1[e]); }
        u32x4 o;
#pragma unroll
        for (int e = 0; e < 4; ++e) o[e] = pk2(r[2 * e] * lo2f(g[e]), r[2 * e + 1] * hi2f(g[e]));
        *(u32x4*)(oa + row * 2048 + 1024 + col) = o; }
  }
};
struct EpiRes {
  static constexpr bool PERM = false, AFTER_DRAIN = false, MIDSCALE = false;
  const float* xres; float* out; const float* gate;
  __device__ __forceinline__ void operator()(const f32x4 (&acc)[2][2][4][2], const Unit& u, int wr, int wc, int fr_, int fq_) const {
    int fr = fr_, fq = fq_; asm volatile("" : "+v"(fr), "+v"(fq));
    const float* xres = this->xres; float* out = this->out; const float* gate = this->gate; asm volatile("" : "+s"(xres), "+s"(out), "+s"(gate));
    const int row0 = u.pm * BM + wr * 64 + fr, col0 = u.pn * BM + wc * 32 + 4 * fq;
    f32x4 gv[2][2];
#pragma unroll
    for (int bj = 0; bj < 2; ++bj)
#pragma unroll
      for (int n = 0; n < 2; ++n) gv[bj][n] = *(const f32x4*)(gate + col0 + bj * HALF + n * 16);
#pragma unroll
    for (int ai = 0; ai < 2; ++ai)
#pragma unroll
      for (int m = 0; m < 4; ++m) { const size_t off = (size_t)(row0 + ai * HALF + m * 16) * DM + col0;
#pragma unroll
        for (int bj = 0; bj < 2; ++bj)
#pragma unroll
          for (int n = 0; n < 2; ++n) { const f32x4 xr = *(const f32x4*)(xres + off + bj * HALF + n * 16);
            *(f32x4*)(out + off + bj * HALF + n * 16) = xr + gv[bj][n] * acc[ai][bj][m][n]; } }
  }
};
struct EpiResX {
  static constexpr bool PERM = false, AFTER_DRAIN = false, MIDSCALE = false;
  const float* xres; float* out; const float* gate; bf16_t* xb; float* ssq1;
  __device__ __forceinline__ void operator()(const f32x4 (&acc)[2][2][4][2], const Unit& u, int wr, int wc, int fr_, int fq_) const {
    int fr = fr_, fq = fq_; asm volatile("" : "+v"(fr), "+v"(fq));
    const float* xres = this->xres; float* out = this->out; const float* gate = this->gate; asm volatile("" : "+s"(xres), "+s"(out), "+s"(gate));
    bf16_t* xbp = this->xb; float* sqp = this->ssq1; asm volatile("" : "+s"(xbp), "+s"(sqp));
    const int row0 = u.pm * BM + wr * 64 + fr, col0 = u.pn * BM + wc * 32 + 4 * fq;
    f32x4 gv[2][2];
#pragma unroll
    for (int bj = 0; bj < 2; ++bj)
#pragma unroll
      for (int n = 0; n < 2; ++n) gv[bj][n] = *(const f32x4*)(gate + col0 + bj * HALF + n * 16);
#pragma unroll
    for (int ai = 0; ai < 2; ++ai)
#pragma unroll
      for (int m = 0; m < 4; ++m) { const size_t off = (size_t)(row0 + ai * HALF + m * 16) * DM + col0; float s = 0.f;
#pragma unroll
        for (int bj = 0; bj < 2; ++bj)
#pragma unroll
          for (int n = 0; n < 2; ++n) { const f32x4 xr = *(const f32x4*)(xres + off + bj * HALF + n * 16);
            const f32x4 v = xr + gv[bj][n] * acc[ai][bj][m][n];
            *(f32x4*)(out + off + bj * HALF + n * 16) = v;
            u32x2 w = {pk2(v[0], v[1]), pk2(v[2], v[3])}; *(u32x2*)(xbp + off + bj * HALF + n * 16) = w;
            s += v[0] * v[0] + v[1] * v[1] + v[2] * v[2] + v[3] * v[3]; }
        s += __shfl_xor(s, 16); s += __shfl_xor(s, 32);
        if (fq == 0) atomicAdd(sqp + row0 + ai * HALF + m * 16, s); }
  }
};
struct EpiResScale {
  static constexpr bool PERM = false, AFTER_DRAIN = false, MIDSCALE = true;
  const float* xres; float* out; const float* gate; const float* ssq;
  __device__ __forceinline__ void midscale(f32x4 (&acc)[2][2][4][2], const Unit& u, int wr, int fr_) const {
    int fr = fr_; asm volatile("" : "+v"(fr)); const float* sq = this->ssq; asm volatile("" : "+s"(sq));
#pragma unroll
    for (int ai = 0; ai < 2; ++ai)
#pragma unroll
      for (int m = 0; m < 4; ++m) { const int row = u.pm * BM + ai * HALF + wr * 64 + m * 16 + fr;
        const float s0 = sq[(size_t)row * 2], s1 = sq[(size_t)row * 2 + 1]; const float rstd = rsqrtf((s0 + s1) * (1.f / 1024.f) + EPS);
#pragma unroll
        for (int bj = 0; bj < 2; ++bj)
#pragma unroll
          for (int n = 0; n < 2; ++n) acc[ai][bj][m][n] *= rstd; }
  }
  __device__ __forceinline__ void operator()(const f32x4 (&acc)[2][2][4][2], const Unit& u, int wr, int wc, int fr_, int fq_) const {
    int fr = fr_, fq = fq_; asm volatile("" : "+v"(fr), "+v"(fq));
    const float* xres = this->xres; float* out = this->out; const float* gate = this->gate; asm volatile("" : "+s"(xres), "+s"(out), "+s"(gate));
    const int row0 = u.pm * BM + wr * 64 + fr, col0 = u.pn * BM + wc * 32 + 4 * fq;
    f32x4 gv[2][2];
#pragma unroll
    for (int bj = 0; bj < 2; ++bj)
#pragma unroll
      for (int n = 0; n < 2; ++n) gv[bj][n] = *(const f32x4*)(gate + col0 + bj * HALF + n * 16);
#pragma unroll
    for (int ai = 0; ai < 2; ++ai)
#pragma unroll
      for (int m = 0; m < 4; ++m) { const size_t off = (size_t)(row0 + ai * HALF + m * 16) * DM + col0;
#pragma unroll
        for (int bj = 0; bj < 2; ++bj)
#pragma unroll
          for (int n = 0; n < 2; ++n) { const f32x4 xr = *(const f32x4*)(xres + off + bj * HALF + n * 16);
            *(f32x4*)(out + off + bj * HALF + n * 16) = xr + gv[bj][n] * acc[ai][bj][m][n]; } }
  }
};
}
using bf16 = bf16_t;
#define KSWZ(row, colB) ((row) * 256 + ((colB) ^ (((row) & 7) << 4)))
#define SBAR() __builtin_amdgcn_sched_barrier(0)
__device__ __forceinline__ int crow(int r, int hi) { return (r & 3) + 8 * (r >> 2) + 4 * hi; }
__device__ __forceinline__ unsigned cvtpk(float lo, float hi) {
  unsigned r; asm volatile("v_cvt_pk_bf16_f32 %0, %1, %2" : "=v"(r) : "v"(lo), "v"(hi)); return r;
}
__device__ __forceinline__ void partialSM(f32x16& p0, f32x16& p1, float& m_reg, float& mn, float& alpha) {
  constexpr float C = SCALE * 1.4426950408889634f;
  float pmax = p0[0]; for (int r = 1; r < 16; ++r) pmax = fmaxf(pmax, p0[r]); for (int r = 0; r < 16; ++r) pmax = fmaxf(pmax, p1[r]);
  { auto rr = __builtin_amdgcn_permlane32_swap(__float_as_uint(pmax), __float_as_uint(pmax), false, false);
    pmax = fmaxf(__uint_as_float(rr[0]), __uint_as_float(rr[1])); }
  if (__builtin_expect(__all(pmax - m_reg <= THR / SCALE), 1)) { mn = m_reg; alpha = 1.f; }
  else { mn = fmaxf(m_reg, pmax); alpha = __builtin_amdgcn_exp2f((m_reg - mn) * C); m_reg = mn; }
  float mnC = -mn * C;
  for (int r = 0; r < 16; ++r) p0[r] = fmaf(p0[r], C, mnC); for (int r = 0; r < 16; ++r) p1[r] = fmaf(p1[r], C, mnC);
  for (int r = 0; r < 16; ++r) p0[r] = __builtin_amdgcn_exp2f(p0[r]);
}
__device__ __forceinline__ void finishSM(f32x16& p0, f32x16& p1, float alpha, float& l_reg, bf16x8& pa0, bf16x8& pa1, bf16x8& pa2, bf16x8& pa3) {
  for (int r = 0; r < 16; ++r) p1[r] = __builtin_amdgcn_exp2f(p1[r]);
  float ps = 0; for (int r = 0; r < 16; ++r) ps += p0[r]; for (int r = 0; r < 16; ++r) ps += p1[r];
  { auto rr = __builtin_amdgcn_permlane32_swap(__float_as_uint(ps), __float_as_uint(ps), false, false);
    ps = __uint_as_float(rr[0]) + __uint_as_float(rr[1]); }
  l_reg = l_reg * alpha + ps;
#define PK4(P, BASE, OUT) do { unsigned a0 = cvtpk(P[BASE + 0], P[BASE + 1]), a1 = cvtpk(P[BASE + 2], P[BASE + 3]);   \
    unsigned b0 = cvtpk(P[BASE + 4], P[BASE + 5]), b1 = cvtpk(P[BASE + 6], P[BASE + 7]);                              \
    auto r0 = __builtin_amdgcn_permlane32_swap(a0, b0, false, false); auto r1 = __builtin_amdgcn_permlane32_swap(a1, b1, false, false); \
    u32x4 w = {r0[0], r1[0], r0[1], r1[1]}; OUT = *reinterpret_cast<bf16x8*>(&w); } while (0)
  PK4(p0, 0, pa0); PK4(p0, 8, pa1); PK4(p1, 0, pa2); PK4(p1, 8, pa3);
#undef PK4
}
template <bool ZERO, bool QLDS> __device__ __forceinline__ void qkt(f32x16& p0, f32x16& p1, const bf16* Ks, const bf16x8* qr, int r32, int hi, const char* qrow) {
  if (ZERO) { p0 = f32x16{}; p1 = f32x16{}; }
  for (int d0 = 0; d0 < 8; ++d0) { int cb = (d0 * 16 + hi * 8) * 2;
    bf16x8 b0 = *reinterpret_cast<const bf16x8*>((const char*)Ks + KSWZ(r32, cb));
    bf16x8 b1 = *reinterpret_cast<const bf16x8*>((const char*)Ks + KSWZ(32 + r32, cb));
    bf16x8 q; if (QLDS) q = *reinterpret_cast<const bf16x8*>(qrow + (cb ^ ((r32 & 7) << 4))); else q = qr[d0];
    p0 = __builtin_amdgcn_mfma_f32_32x32x16_bf16(b0, q, p0, 0, 0, 0);
    p1 = __builtin_amdgcn_mfma_f32_32x32x16_bf16(b1, q, p1, 0, 0, 0); }
}
__device__ __forceinline__ int v_st(int k, int c) { const int kk = (k & ~0xC) | ((k & 4) << 1) | ((k & 8) >> 1); return ((kk >> 3) * 4 + (c >> 5)) * 512 + ((kk & 7) * 32 + (c & 31)) * 2; }
__device__ __forceinline__ int v_rd_base(int lane) { return ((lane & 3) << 3) | (((lane >> 2) & 3) << 6) | (((lane >> 4) & 1) << 5) | (((lane >> 5) & 1) << 8); }
constexpr int v_rd_off(int d0, int ks, int half) { return d0 * 512 + ks * 4096 + half * 2048; }
template <int OFF> __device__ __forceinline__ s16x4 tr_read(int vb) {
  s16x4 r; asm volatile("ds_read_b64_tr_b16 %0, %1 offset:%2" : "=&v"(r) : "v"(vb), "i"(OFF) : "memory"); return r;
}
template <int D0> __device__ __forceinline__ void pv_one(f32x16& od, int vb, bf16x8 pa0, bf16x8 pa1, bf16x8 pa2, bf16x8 pa3) {
  const s16x4 l0 = tr_read<v_rd_off(D0, 0, 0)>(vb), h0 = tr_read<v_rd_off(D0, 0, 1)>(vb), l1 = tr_read<v_rd_off(D0, 1, 0)>(vb), h1 = tr_read<v_rd_off(D0, 1, 1)>(vb);
  const s16x4 l2 = tr_read<v_rd_off(D0, 2, 0)>(vb), h2 = tr_read<v_rd_off(D0, 2, 1)>(vb), l3 = tr_read<v_rd_off(D0, 3, 0)>(vb), h3 = tr_read<v_rd_off(D0, 3, 1)>(vb);
  asm volatile("s_waitcnt lgkmcnt(0)" ::: "memory"); SBAR();
#define PK(L, H) (bf16x8){L[0], L[1], L[2], L[3], H[0], H[1], H[2], H[3]}
  od = __builtin_amdgcn_mfma_f32_32x32x16_bf16(pa0, PK(l0, h0), od, 0, 0, 0);
  od = __builtin_amdgcn_mfma_f32_32x32x16_bf16(pa1, PK(l1, h1), od, 0, 0, 0);
  od = __builtin_amdgcn_mfma_f32_32x32x16_bf16(pa2, PK(l2, h2), od, 0, 0, 0);
  od = __builtin_amdgcn_mfma_f32_32x32x16_bf16(pa3, PK(l3, h3), od, 0, 0, 0);
#undef PK
}
__device__ __forceinline__ void pv_d0(f32x16* o, int vb, bf16x8 pa0, bf16x8 pa1, bf16x8 pa2, bf16x8 pa3) {
  pv_one<0>(o[0], vb, pa0, pa1, pa2, pa3); pv_one<1>(o[1], vb, pa0, pa1, pa2, pa3); pv_one<2>(o[2], vb, pa0, pa1, pa2, pa3); pv_one<3>(o[3], vb, pa0, pa1, pa2, pa3);
}
constexpr size_t SHM_V = 64 * 128 * 2, SHM_K = 64 * 128 * 2, SHM_ATTN = 2 * SHM_V + 2 * SHM_K + 8 * 64 * 4;
template <int MODE, int LDQ, int LDK, int LDO, int SDEPTH>
__device__ __forceinline__ void attn_body(const bf16_t* __restrict__ Qb, const bf16_t* __restrict__ Kh, const bf16_t* __restrict__ Vh, const bf16_t* __restrict__ Gb,
                                          bf16_t* __restrict__ Ob, const float* __restrict__ qnw, const int NT, const int tok0, const int r0, const int t0, char* lds, const int tid) {
  const int wid = __builtin_amdgcn_readfirstlane(tid >> 6), lane = tid & 63, r32 = lane & 31, hi = lane >> 5;
  bf16_t* V_lds = (bf16_t*)lds; bf16_t* K_lds = (bf16_t*)(lds + 2 * SHM_V);
  float* ws = (float*)(lds + 2 * SHM_V + 2 * SHM_K) + wid * 64; float* li_l = ws; float* al_l = ws + 32;
  const __attribute__((address_space(3))) float* biasT = (const __attribute__((address_space(3))) float*)(lds + SHM_ATTN) + 64;
  float m_reg = MODE ? -1e29f : -1e30f, l_reg = 0; f32x16 o[4] = {}; bf16x8 qr[8];
  char* qt = MODE ? lds + 73728 : lds;
  {
    const int prow_ = tid >> 1, half = tid & 1;
    const bf16_t* Qw = Qb + (long)prow_ * LDQ + half * 64;
    u32x4 raw[8]; float ss = 0.f;
#pragma unroll
    for (int j = 0; j < 8; ++j) { raw[j] = *reinterpret_cast<const u32x4*>(Qw + j * 8);
#pragma unroll
      for (int e = 0; e < 4; ++e) { const float a = lo2f(raw[j][e]), b = hi2f(raw[j][e]); ss += a * a + b * b; } }
    ss += __shfl_xor(ss, 1);
    const float rstd = rsqrtf(ss * (1.f / 128.f) + EPS);
    const int tok = tok0 + prow_; const float pos = half ? (float)(tok & 63) : (float)(tok >> 6);
#pragma unroll
    for (int j = 0; j < 8; ++j) {
      const f32x4 w0 = *reinterpret_cast<const f32x4*>(qnw + half * 64 + j * 8), w1 = *reinterpret_cast<const f32x4*>(qnw + half * 64 + j * 8 + 4);
      float v[8];
#pragma unroll
      for (int e = 0; e < 4; ++e) { v[2 * e] = lo2f(raw[j][e]) * rstd; v[2 * e + 1] = hi2f(raw[j][e]) * rstd; }
      v[0] *= w0[0]; v[1] *= w0[1]; v[2] *= w0[2]; v[3] *= w0[3]; v[4] *= w1[0]; v[5] *= w1[1]; v[6] *= w1[2]; v[7] *= w1[3];
      if (MODE == 0) {
#pragma unroll
        for (int e2 = 0; e2 < 4; ++e2) { const int i = j * 4 + e2;
          const float inv = exp2f(-(float)i * (13.287712379549449f / 32.f)); float sn, cs; sincos_rev(pos * inv, sn, cs);
          const float x1 = v[2 * e2], x2 = v[2 * e2 + 1]; v[2 * e2] = x1 * cs - x2 * sn; v[2 * e2 + 1] = x1 * sn + x2 * cs; } }
      u32x4 w = {pk2(v[0], v[1]), pk2(v[2], v[3]), pk2(v[4], v[5]), pk2(v[6], v[7])};
      *reinterpret_cast<u32x4*>(qt + KSWZ(prow_, (half * 64 + j * 8) * 2)) = w; }
    __syncthreads();
    if (MODE == 0) {
#pragma unroll
      for (int d0 = 0; d0 < 8; ++d0) qr[d0] = *reinterpret_cast<const bf16x8*>(lds + KSWZ(wid * 32 + r32, (d0 * 16 + hi * 8) * 2));
      __syncthreads(); }
  }
  const char* qrow = qt + (wid * 32 + r32) * 256;
  const int rq = r0 + (wid >> 1), qc = (wid & 1) * 32 + r32, rs = min(max(rq - 4, 0), 248), cs0 = min(max(qc - 8, 0), 48);
  const int mbase = 232 - rq * 31 - qc;
#define NA_INIT(P0, P1, J) do { if (MODE == 1) { const int kt = t0 + (J); \
    if ((kt >= rs) && (kt < rs + 8)) { int ib = mbase + kt * 31, csx = cs0; asm volatile("" : "+v"(ib), "+v"(csx)); \
      _Pragma("unroll") for (int r = 0; r < 16; ++r) { const int kc0 = crow(r, hi), kc1 = 32 + kc0; \
        const bool ok0 = (unsigned)(kc0 - csx) < 16u, ok1 = (unsigned)(kc1 - csx) < 16u; \
        const float b0 = biasT[ib + kc0], b1 = biasT[ib + kc1]; \
        P0[r] = ok0 ? b0 : -1e30f; P1[r] = ok1 ? b1 : -1e30f; } } \
    } } while (0)
#define TILE_OK(J) (MODE == 0 || ((t0 + (J)) >= rs && (t0 + (J)) < rs + 8))
#define QKT(P0, P1, KP, J, V) do { V = TILE_OK(J); if (V) { NA_INIT(P0, P1, J); qkt<MODE == 0, MODE == 1>(P0, P1, KP, qr, r32, hi, qrow); } } while (0)
#define PSM(P0, P1, MN, AL, V) do { if (V) partialSM(P0, P1, m_reg, MN, AL); else { MN = m_reg; AL = 1.f; } } while (0)
#define FSM_PV(P0, P1, AL, VB, V) do { if (V) { finishSM(P0, P1, AL, l_reg, pa0, pa1, pa2, pa3); SBAR(); } } while (0)
  const int sr = tid >> 4, sc = (tid & 15) * 8, vst0 = v_st(sr, sc), vst1 = v_st(32 + sr, sc);
  const int vb0 = (int)(uintptr_t)V_lds + v_rd_base(lane);
  struct { bf16x8 vs0, vs1, ks0, ks1; } sr_[SDEPTH];
#define LD8(p) (*reinterpret_cast<const bf16x8*>(p))
#define SLOAD(i, k0) do { sr_[i].vs0 = LD8(&Vh[(long)((k0) + sr) * LDK + sc]); sr_[i].vs1 = LD8(&Vh[(long)((k0) + 32 + sr) * LDK + sc]); \
    sr_[i].ks0 = LD8(&Kh[(long)((k0) + sr) * LDK + sc]); sr_[i].ks1 = LD8(&Kh[(long)((k0) + 32 + sr) * LDK + sc]); } while (0)
#define SWRITE(b, i) do { *(bf16x8*)((char*)V_lds + (b) * SHM_V + vst0) = sr_[i].vs0;          \
    *(bf16x8*)((char*)V_lds + (b) * SHM_V + vst1) = sr_[i].vs1; int kc = sc * 2;               \
    *(bf16x8*)((char*)K_lds + (b) * SHM_K + KSWZ(sr, kc)) = sr_[i].ks0;                       \
    *(bf16x8*)((char*)K_lds + (b) * SHM_K + KSWZ(32 + sr, kc)) = sr_[i].ks1; } while (0)
#define SWAIT() do { if constexpr (SDEPTH == 2) asm volatile("s_waitcnt vmcnt(4)" ::: "memory"); else asm volatile("s_waitcnt vmcnt(0)" ::: "memory"); } while (0)
#define RESC(a) do { if (__any((a) < 1.f)) { if (hi == 0) al_l[r32] = (a); asm volatile("s_waitcnt lgkmcnt(0)" ::: "memory"); \
    for (int d = 0; d < 4; ++d) for (int r = 0; r < 16; ++r) o[d][r] *= al_l[crow(r, hi)]; } } while (0)
  f32x16 pA0, pA1, pB0, pB1; float mnA, mnB, alA, alB; bf16x8 pa0, pa1, pa2, pa3;
  constexpr int SE = 0, SO = SDEPTH - 1, KVBLK = 64;
  bool vA = true, vB = true;
  SLOAD(SE, 0); asm volatile("s_waitcnt vmcnt(0)" ::: "memory"); SWRITE(0, SE); __syncthreads();
  QKT(pA0, pA1, K_lds, 0, vA); PSM(pA0, pA1, mnA, alA, vA);
  SLOAD(SO, KVBLK); if constexpr (SDEPTH == 2) { if (2 < NT) SLOAD(SE, 2 * KVBLK); }
  SWAIT(); SWRITE(1, SO); __syncthreads();
  for (int j = 1; j + 1 < NT; j += 2) {
    SBAR(); QKT(pB0, pB1, (bf16_t*)((char*)K_lds + SHM_K), j, vB);
    if (vA) finishSM(pA0, pA1, alA, l_reg, pa0, pa1, pa2, pa3); SBAR();
    SLOAD(SO, (j + SDEPTH) * KVBLK); SBAR();
    if (vA) pv_d0(o, vb0, pa0, pa1, pa2, pa3); PSM(pB0, pB1, mnB, alB, vB);
    __syncthreads(); SWAIT(); SWRITE(0, SE);
    RESC(alB); __syncthreads();
    SBAR(); QKT(pA0, pA1, K_lds, j + 1, vA);
    if (vB) finishSM(pB0, pB1, alB, l_reg, pa0, pa1, pa2, pa3); SBAR();
    if (SDEPTH == 1 || j + 3 < NT) SLOAD(SE, (j + 1 + SDEPTH) * KVBLK); SBAR();
    if (vB) pv_d0(o, vb0 + (int)SHM_V, pa0, pa1, pa2, pa3); PSM(pA0, pA1, mnA, alA, vA);
    __syncthreads(); SWAIT(); SWRITE(1, SO);
    RESC(alA); __syncthreads();
  }
  SBAR(); QKT(pB0, pB1, (bf16_t*)((char*)K_lds + SHM_K), NT - 1, vB);
  if (vA) finishSM(pA0, pA1, alA, l_reg, pa0, pa1, pa2, pa3); SBAR();
  if (vA) pv_d0(o, vb0, pa0, pa1, pa2, pa3); PSM(pB0, pB1, mnB, alB, vB);
  __syncthreads(); RESC(alB);
  if (vB) { finishSM(pB0, pB1, alB, l_reg, pa0, pa1, pa2, pa3); SBAR();
    pv_d0(o, vb0 + (int)SHM_V, pa0, pa1, pa2, pa3); }
  if (hi == 0) li_l[r32] = l_reg; asm volatile("s_waitcnt lgkmcnt(0)" ::: "memory");
  float rli[16];
#pragma unroll
  for (int r = 0; r < 16; ++r) rli[r] = __builtin_amdgcn_rcpf(li_l[crow(r, hi)]);
  __syncthreads();
  { bf16_t* Ot = (bf16_t*)lds + wid * 32 * 128;
#pragma unroll
    for (int r = 0; r < 16; ++r)
#pragma unroll
      for (int d0 = 0; d0 < 4; ++d0) Ot[crow(r, hi) * 128 + d0 * 32 + r32] = f2bf(o[d0][r] * rli[r]);
    WAVE_LDS_FENCE();
#pragma unroll 2
    for (int i = 0; i < 8; ++i) { const int id = lane + 64 * i, row = id >> 4, cc = id & 15;
      const u32x4 ov = *reinterpret_cast<const u32x4*>(Ot + row * 128 + cc * 8);
      const u32x4 gv = *reinterpret_cast<const u32x4*>(Gb + (long)(wid * 32 + row) * 1024 + cc * 8);
      u32x4 w;
#pragma unroll
      for (int e = 0; e < 4; ++e) w[e] = pk2(lo2f(ov[e]) * lo2f(gv[e]), hi2f(ov[e]) * hi2f(gv[e]));
      *reinterpret_cast<u32x4*>(Ob + (long)(wid * 32 + row) * LDO + cc * 8) = w; }
  }
#undef NA_INIT
#undef QKT
#undef PSM
#undef FSM_PV
#undef TILE_OK
#undef LD8
#undef SLOAD
#undef SWRITE
#undef SWAIT
#undef RESC
}
__device__ __forceinline__ void p0_transpose_item(const float* __restrict__ W, int N, int K, bf16_t* __restrict__ WT, int k0, int nrow0, int srccol0, float* scr, int lane,
                                                  int kd0 = -1, const float* __restrict__ kscale = nullptr) {
  if (kd0 < 0) kd0 = k0;
  if (srccol0 >= 0) {
    f32x4 v[8];
#pragma unroll
    for (int i = 0; i < 8; ++i) v[i] = *(const f32x4*)(W + (size_t)(k0 + 8 * i + (lane >> 3)) * N + srccol0 + (lane & 7) * 4);
    if (kscale) {
#pragma unroll
      for (int i = 0; i < 8; ++i) v[i] *= kscale[k0 + 8 * i + (lane >> 3)]; }
#pragma unroll
    for (int i = 0; i < 8; ++i) { float* s = scr + (8 * i + (lane >> 3)) * 33 + (lane & 7) * 4; s[0] = v[i][0]; s[1] = v[i][1]; s[2] = v[i][2]; s[3] = v[i][3]; }
  } else {
#pragma unroll 8
    for (int i = 0; i < 32; ++i) { const int kk = 2 * i + (lane >> 5); scr[kk * 33 + (lane & 31)] = 0.f; }
  }
  WAVE_LDS_FENCE();
  const int c = lane & 7;
#pragma unroll
  for (int j = 0; j < 4; ++j) { const int n = (lane >> 3) + 8 * j; const float* s = scr + (8 * c) * 33 + n;
    u32x4 o; o[0] = pk2(s[0 * 33], s[1 * 33]); o[1] = pk2(s[2 * 33], s[3 * 33]); o[2] = pk2(s[4 * 33], s[5 * 33]); o[3] = pk2(s[6 * 33], s[7 * 33]);
    *(u32x4*)(WT + (size_t)(nrow0 + n) * K + kd0 + 8 * c) = o; }
  WAVE_LDS_FENCE();
}
__device__ __forceinline__ void p0_phase(const Params& P, unsigned char* lds, int bid, int G, int tid, int wid, int lane) {
  unsigned char* ws = P.ws;
  float* red = (float*)lds; float* sc = (float*)(lds + 4096);
  if (bid < 192) { for (int k = tid; k < DM; k += 512) sc[k] = silu_f(P.c[k]); __syncthreads(); }
  for (int item = bid; item < 192; item += G) {
    const int layer = item / 96, cgi = item % 96;
    const float* W = layer ? P.o_ada_w : P.e_ada_w; const float* bias = layer ? P.o_ada_b : P.e_ada_b;
    f32x4 a4 = {0.f, 0.f, 0.f, 0.f}; const int k0 = wid * 256 + (lane >> 4), c4 = cgi * 64 + (lane & 15) * 4;
#pragma unroll 8
    for (int k = 0; k < 256; k += 4) a4 += *(const f32x4*)(W + (size_t)(k0 + k) * 6144 + c4) * sc[k0 + k];
#pragma unroll
    for (int e = 0; e < 4; ++e) { a4[e] += __shfl_xor(a4[e], 16); a4[e] += __shfl_xor(a4[e], 32); }
    if (lane < 16) *(f32x4*)(red + wid * 64 + lane * 4) = a4;
    __syncthreads();
    if (tid < 64) { float s = 0.f;
#pragma unroll
      for (int i = 0; i < 8; ++i) s += red[i * 64 + tid];
      ((float*)(ws + O_MOD))[layer * 6144 + cgi * 64 + tid] = s + bias[cgi * 64 + tid]; }
    __syncthreads();
  }
  float* scr = (float*)(lds + 16384 + wid * 8448);
  const int gw = bid * 8 + wid, ngw = G * 8;
  constexpr int I0 = 32 * 144;
  for (int it = gw; it < I0; it += ngw) {
    int r = it;
    if (r < I0) { const int kb = r / 144, nb = r % 144; p0_transpose_item(P.e_w_in, 4608, 2048, (bf16_t*)(ws + O_WT_IN_E), 64 * kb, 32 * nb, 32 * nb, scr, lane); continue; } r -= I0;
  }
  for (int i = bid * 512 + tid; i < L + 6912; i += G * 512) { if (i < L) ((float*)(ws + O_SSQ1))[i] = 0.f; else ((float*)(ws + O_SWO))[i - L] = 0.f; }
  for (int idx = bid * 512 + tid; idx < 2 * 64 * 64; idx += G * 512) {
    const int dg = idx >> 6, p = idx & 63;
    const float lr = P.s5_lam_re[idx], li = P.s5_lam_im[idx], dt = __expf(P.s5_log_step[dg]);
    const float mag = __expf(lr * dt); float sn, cs; sincos_rev(li * dt, sn, cs);
    const float abr = mag * cs, abi = mag * sn, den = lr * lr + li * li, nr = abr - 1.f;
    const float fr = (nr * lr + abi * li) / den, fi = (abi * lr - nr * li) / den;
    float* ab = (float*)(ws + O_AB); ab[idx * 2] = abr; ab[idx * 2 + 1] = abi;
    bf16_t* bbar = (bf16_t*)(ws + O_BBAR); bf16_t* cmat = (bf16_t*)(ws + O_CMAT);
    for (int i = 0; i < 16; ++i) { const float br = P.s5_b_re[(size_t)idx * 16 + i], bi = P.s5_b_im[(size_t)idx * 16 + i];
      bbar[((size_t)dg * 128 + p) * 16 + i] = f2bf(fr * br - fi * bi); bbar[((size_t)dg * 128 + 64 + p) * 16 + i] = f2bf(fr * bi + fi * br); }
    for (int ch = 0; ch < 16; ++ch) { const float cr = P.s5_c_re[((size_t)dg * 16 + ch) * 64 + p], ci = P.s5_c_im[((size_t)dg * 16 + ch) * 64 + p];
      cmat[((size_t)dg * 16 + ch) * 128 + p] = f2bf(cr); cmat[((size_t)dg * 16 + ch) * 128 + 64 + p] = f2bf(-ci); }
  }
}
__device__ __forceinline__ void w_in_o_phase(const Params& P, unsigned char* lds, int gw, int ngw, int wid, int lane) {
  const float* mod1 = (const float*)(P.ws + O_MOD) + 6144; float* sW = (float*)(P.ws + O_SWO);
  const float* W = P.o_w_in; bf16_t* WT = (bf16_t*)(P.ws + O_WT_IN_O); constexpr int N = 6688, K = 2048;
  float* scr = (float*)(lds + 16384 + wid * 8448);
  for (int it = gw; it < 32 * 216; it += ngw) {
    const int kb = it / 216, nb = it % 216, k0 = 64 * kb, n0 = 32 * nb;
    if (n0 < N) {
      f32x4 v[8]; f32x4 ps = {0.f, 0.f, 0.f, 0.f};
#pragma unroll
      for (int i = 0; i < 8; ++i) v[i] = *(const f32x4*)(W + (size_t)(k0 + 8 * i + (lane >> 3)) * N + n0 + (lane & 7) * 4);
#pragma unroll
      for (int i = 0; i < 8; ++i) { const int k = k0 + 8 * i + (lane >> 3); const float sh = mod1[k], a = P.o_norm_g[k] * (1.f + mod1[2048 + k]);
        ps += v[i] * sh; v[i] *= a; }
#pragma unroll
      for (int e = 0; e < 4; ++e) { ps[e] += __shfl_xor(ps[e], 8); ps[e] += __shfl_xor(ps[e], 16); ps[e] += __shfl_xor(ps[e], 32); }
      if ((lane >> 3) == 0) {
#pragma unroll
        for (int e = 0; e < 4; ++e) atomicAdd(sW + n0 + (lane & 7) * 4 + e, ps[e]); }
#pragma unroll
      for (int i = 0; i < 8; ++i) { float* s = scr + (8 * i + (lane >> 3)) * 33 + (lane & 7) * 4; s[0] = v[i][0]; s[1] = v[i][1]; s[2] = v[i][2]; s[3] = v[i][3]; }
    } else {
#pragma unroll 8
      for (int i = 0; i < 32; ++i) { const int kk = 2 * i + (lane >> 5); scr[kk * 33 + (lane & 31)] = 0.f; }
    }
    WAVE_LDS_FENCE();
    const int c = lane & 7;
#pragma unroll
    for (int j = 0; j < 4; ++j) { const int n = (lane >> 3) + 8 * j; const float* s = scr + (8 * c) * 33 + n;
      u32x4 o; o[0] = pk2(s[0 * 33], s[1 * 33]); o[1] = pk2(s[2 * 33], s[3 * 33]); o[2] = pk2(s[4 * 33], s[5 * 33]); o[3] = pk2(s[6 * 33], s[7 * 33]);
      *(u32x4*)(WT + (size_t)(n0 + n) * K + k0 + 8 * c) = o; }
    WAVE_LDS_FENCE();
  }
}
__device__ __forceinline__ void gemm_tail_fill(const Params& P, unsigned char* lds, int wv, int nwv, int wid, int lane) {
  unsigned char* ws = P.ws; float* scr = (float*)(lds + 16384 + wid * 8448);
  constexpr int I1 = 16 * 64, I2 = 32 * 64, I4 = 32 * 64;
  for (int it = wv; it < I1 + I2 + I4; it += nwv) {
    int r = it;
    if (r < I1) { const int kb = r / 64, nb = r % 64, n0 = 32 * nb, pn = n0 >> 8, bj = (n0 >> 7) & 1, j0 = n0 & 127;
                  p0_transpose_item(P.s5_w_glu, 2048, 1024, (bf16_t*)(ws + O_WT_GLU), 64 * kb, n0, 1024 * bj + 128 * pn + j0, scr, lane); continue; } r -= I1;
    if (r < I2) { const int kb = r / 64, nb = r % 64; p0_transpose_item(P.e_w_out, 2048, 2048, (bf16_t*)(ws + O_WT_OUT_E), 64 * kb, 32 * nb, 32 * nb, scr, lane); continue; } r -= I2;
    { const int kb = r / 64, nb = r % 64, k0 = 64 * kb;
      p0_transpose_item(P.o_w_out, 2048, 2048, (bf16_t*)(ws + O_WT_OUT_O), k0, 32 * nb, 32 * nb, scr, lane, (k0 + 1024) & 2047, k0 >= 1024 ? P.ssd_norm_w - 1024 : nullptr); }
  }
  w_in_o_phase(P, lds, wv, nwv, wid, lane);
}
__device__ __forceinline__ void norm_mod_phase(const float* __restrict__ X, const float* __restrict__ g, const float* __restrict__ mod, bf16_t* __restrict__ H, int gw, int ngw, int lane) {
  for (int row = gw; row < L; row += ngw) {
    const f32x4* xr = (const f32x4*)(X + (size_t)row * DM) + lane;
    f32x4 v[8]; float ss = 0.f;
#pragma unroll
    for (int j = 0; j < 8; ++j) { v[j] = xr[64 * j]; ss += v[j][0] * v[j][0] + v[j][1] * v[j][1] + v[j][2] * v[j][2] + v[j][3] * v[j][3]; }
    const float rstd = rsqrtf(wave_sum(ss) * (1.f / DM) + EPS);
#pragma unroll
    for (int j = 0; j < 8; ++j) { const int col = (lane + 64 * j) * 4;
      const f32x4 g4 = *(const f32x4*)(g + col), sh = *(const f32x4*)(mod + col), sc4 = *(const f32x4*)(mod + DM + col);
      f32x4 o = v[j] * rstd * g4 * (sc4 + 1.f) + sh;
      u32x2 w = {pk2(o[0], o[1]), pk2(o[2], o[3])};
      *(u32x2*)(H + (size_t)row * DM + col) = w; }
  }
}
__device__ __forceinline__ void kprep_gqa_phase(const Params& P, int gw, int ngw, int lane) {
  const bf16_t* kr = (const bf16_t*)(P.ws + O_KR); bf16_t* kn = (bf16_t*)(P.ws + O_KN);
  const int sub = lane & 15, rsel = lane >> 4;
  const f32x4 w0 = *(const f32x4*)(P.e_k_norm + sub * 8), w1 = *(const f32x4*)(P.e_k_norm + sub * 8 + 4);
  float inv[4];
#pragma unroll
  for (int e = 0; e < 4; ++e) inv[e] = exp2f(-(float)((sub * 4 + e) & 31) * (13.287712379549449f / 32.f));
  for (int r0 = gw * 16; r0 < L * 2; r0 += ngw * 16) {
    u32x4 w[4];
#pragma unroll
    for (int k = 0; k < 4; ++k) w[k] = *(const u32x4*)(kr + (size_t)(r0 + k * 4 + rsel) * 128 + sub * 8);
#pragma unroll
    for (int k = 0; k < 4; ++k) { const int row = r0 + k * 4 + rsel, tok = row >> 1; float v[8]; float ss = 0.f;
#pragma unroll
      for (int e = 0; e < 4; ++e) { v[2 * e] = lo2f(w[k][e]); v[2 * e + 1] = hi2f(w[k][e]); ss += v[2 * e] * v[2 * e] + v[2 * e + 1] * v[2 * e + 1]; }
      ss += __shfl_xor(ss, 1); ss += __shfl_xor(ss, 2); ss += __shfl_xor(ss, 4); ss += __shfl_xor(ss, 8);
      const float rstd = rsqrtf(ss * (1.f / 128.f) + EPS);
      v[0] *= rstd * w0[0]; v[1] *= rstd * w0[1]; v[2] *= rstd * w0[2]; v[3] *= rstd * w0[3]; v[4] *= rstd * w1[0]; v[5] *= rstd * w1[1]; v[6] *= rstd * w1[2]; v[7] *= rstd * w1[3];
      const float pos = sub < 8 ? (float)(tok >> 6) : (float)(tok & 63);
      u32x4 o;
#pragma unroll
      for (int e = 0; e < 4; ++e) { float sn, cs; sincos_rev(pos * inv[e], sn, cs); o[e] = pk2(v[2 * e] * cs - v[2 * e + 1] * sn, v[2 * e] * sn + v[2 * e + 1] * cs); }
      *(u32x4*)(kn + (size_t)row * 128 + sub * 8) = o; }
  }
}
template <bool PASS2, int DIR>
__device__ __forceinline__ void s5_sub(const bf16x8 ufr, const bf16x8 (&bfr)[8], const bf16x8 (&cfr)[4], float ar, float ai, float& hr, float& hi, f32x4& ya,
                                       float* XS, bf16_t* HS, int lane) {
  const int n = lane & 15, kq = lane >> 4;
  const bf16x8 zero8 = {0, 0, 0, 0, 0, 0, 0, 0}; const f32x4 zero4 = {0.f, 0.f, 0.f, 0.f};
#pragma unroll
  for (int jt = 0; jt < 8; ++jt) { const f32x4 xv = mfma16(ufr, bfr[jt], zero4);
#pragma unroll
    for (int r = 0; r < 4; ++r) XS[(kq * 4 + r) * 132 + jt * 16 + n] = xv[r]; }
  WAVE_LDS_FENCE();
  float xr_[16], xi_[16];
#pragma unroll
  for (int tt = 0; tt < 16; ++tt) { const int t = DIR ? 15 - tt : tt; xr_[tt] = XS[t * 132 + lane]; xi_[tt] = XS[t * 132 + 64 + lane]; }
  WAVE_LDS_FENCE(); __builtin_amdgcn_sched_barrier(0);
#pragma unroll
  for (int tt = 0; tt < 16; ++tt) { const int t = DIR ? 15 - tt : tt; const float xr = xr_[tt], xi = xi_[tt];
    const float nr = ar * hr - ai * hi + xr, ni = ar * hi + ai * hr + xi; hr = nr; hi = ni;
    if (PASS2) { const unsigned pk = pk2(hr, hi); HS[t * 136 + lane] = (bf16_t)(pk & 0xffffu); HS[t * 136 + 64 + lane] = (bf16_t)(pk >> 16); } }
  WAVE_LDS_FENCE();
  if (PASS2) {
    bf16x8 ha[4];
#pragma unroll
    for (int ks = 0; ks < 4; ++ks) ha[ks] = *(const bf16x8*)(HS + n * 136 + ks * 32 + kq * 8);
#pragma unroll
    for (int ks = 0; ks < 4; ++ks) ya = mfma16(ha[ks], cfr[ks], ya);
    WAVE_LDS_FENCE();
  }
}
template <bool PASS2, int DIR>
__device__ __forceinline__ void s5_dir(const Params& P, int c, int g, float* XS, bf16_t* HS, int lane, f32x4 (&yacc)[8], const bf16x8 (&ufr)[8]) {
  const int dg = DIR * 64 + g, n = lane & 15, kq = lane >> 4;
  const bf16_t* bbar = (const bf16_t*)(P.ws + O_BBAR); const bf16_t* cmat = (const bf16_t*)(P.ws + O_CMAT); const float* ab = (const float*)(P.ws + O_AB);
  const bf16_t* U = (const bf16_t*)(P.ws + O_RA + 2 * SZ_LK); float* s5e = (float*)(P.ws + O_S5E);
  const bf16x8 zero8 = {0, 0, 0, 0, 0, 0, 0, 0}; const f32x4 zero4 = {0.f, 0.f, 0.f, 0.f};
  bf16x8 bfr[8];
#pragma unroll
  for (int jt = 0; jt < 8; ++jt) { bfr[jt] = zero8; if (kq < 2) bfr[jt] = *(const bf16x8*)(bbar + ((size_t)dg * 128 + jt * 16 + n) * 16 + kq * 8); }
  const float ar = ab[(dg * 64 + lane) * 2], ai = ab[(dg * 64 + lane) * 2 + 1];
  float hr = 0.f, hi = 0.f;
  bf16x8 cfr[4] = {zero8, zero8, zero8, zero8};
  if (PASS2) {
#pragma unroll
    for (int ks = 0; ks < 4; ++ks) cfr[ks] = *(const bf16x8*)(cmat + ((size_t)dg * 16 + n) * 128 + ks * 32 + kq * 8);
    float tr = ar, ti = ai;
#pragma unroll
    for (int i = 0; i < 7; ++i) { const float nr = tr * tr - ti * ti, ni = 2.f * tr * ti; tr = nr; ti = ni; }
    { const float* e = s5e + ((size_t)(c * 64 + g) * 2 + DIR) * 128; hr = e[lane]; hi = e[64 + lane]; }
  }
  f32x4 dummy = zero4;
#pragma unroll
  for (int s = 0; s < 8; ++s) { const int sb = DIR ? 7 - s : s;
    s5_sub<PASS2, DIR>(ufr[sb], bfr, cfr, ar, ai, hr, hi, PASS2 ? yacc[sb] : dummy, XS, HS, lane);
    __builtin_amdgcn_sched_barrier(0); }
  if (!PASS2) { float* e = s5e + ((size_t)(c * 64 + g) * 2 + DIR) * 128; e[lane] = hr; e[64 + lane] = hi; }
}
__device__ __forceinline__ void s5_carry_phase(const Params& P, int bid, int G, int wid, int lane) {
  float* s5e = (float*)(P.ws + O_S5E); const float* ab = (const float*)(P.ws + O_AB);
  if (wid != 0) return;
  for (int seq = bid; seq < 128; seq += G) {
    const int g = seq & 63, dir = seq >> 6, dg = dir * 64 + g;
    float tr = ab[(dg * 64 + lane) * 2], ti = ab[(dg * 64 + lane) * 2 + 1];
#pragma unroll
    for (int i = 0; i < 7; ++i) { const float nr = tr * tr - ti * ti, ni = 2.f * tr * ti; tr = nr; ti = ni; }
    float hr = 0.f, hi = 0.f;
#pragma unroll 1
    for (int ib = 0; ib < NCH; ib += 16) { float er[16], ei[16];
#pragma unroll
      for (int k = 0; k < 16; ++k) { const int c = dir ? NCH - 1 - (ib + k) : ib + k; const float* e = s5e + ((size_t)(c * 64 + g) * 2 + dir) * 128; er[k] = e[lane]; ei[k] = e[64 + lane]; }
#pragma unroll
      for (int k = 0; k < 16; ++k) { const int c = dir ? NCH - 1 - (ib + k) : ib + k; float* e = s5e + ((size_t)(c * 64 + g) * 2 + dir) * 128;
        e[lane] = hr; e[64 + lane] = hi;
        const float nr = tr * hr - ti * hi + er[k], ni = tr * hi + ti * hr + ei[k]; hr = nr; hi = ni; }
    }
  }
}
template <bool PASS2>
__device__ __forceinline__ void s5_phase(const Params& P, unsigned char* lds, int gw, int ngw, int wid, int lane) {
  float* XS = (float*)(lds + wid * 8448); bf16_t* HS = (bf16_t*)(lds + 8 * 8448 + wid * 4352);
  const bf16_t* U = (const bf16_t*)(P.ws + O_RA + 2 * SZ_LK); bf16_t* Y = (bf16_t*)(P.ws + O_Y);
  for (int task = gw; task < NCH * 64; task += ngw) {
    const int c = task >> 6, g = task & 63;
    f32x4 yacc[8];
#pragma unroll
    for (int i = 0; i < 8; ++i) yacc[i] = (f32x4){0.f, 0.f, 0.f, 0.f};
    bf16x8 ufr[8];
#pragma unroll
    for (int sb = 0; sb < 8; ++sb) { ufr[sb] = (bf16x8){0, 0, 0, 0, 0, 0, 0, 0};
      if ((lane >> 4) < 2) ufr[sb] = *(const bf16x8*)(U + (size_t)(c * 128 + sb * 16 + (lane & 15)) * 1024 + g * 16 + (lane >> 4) * 8); }
    s5_dir<PASS2, 0>(P, c, g, XS, HS, lane, yacc, ufr);
    s5_dir<PASS2, 1>(P, c, g, XS, HS, lane, yacc, ufr);
    if (PASS2) {
      const int n = lane & 15, kq = lane >> 4, ch = g * 16 + n; const float dd = P.s5_d[ch];
#pragma unroll
      for (int sb = 0; sb < 8; ++sb)
#pragma unroll
        for (int r = 0; r < 4; ++r) { const size_t t = (size_t)c * 128 + sb * 16 + kq * 4 + r;
          const float y = yacc[sb][r] + dd * bf2f(U[t * 1024 + ch]);
          const float z = 0.7978845608028654f * (y + 0.044715f * y * y * y);
          const float th = 1.f - 2.f * __builtin_amdgcn_rcpf(1.f + __expf(2.f * z));
          Y[t * 1024 + ch] = f2bf(0.5f * y * (1.f + th)); }
    }
  }
}
__device__ __forceinline__ void prep1_phase(const Params& P, unsigned char* lds, int gw, int ngw, int wid, int lane, bool do_knorm) {
  unsigned char* ws = P.ws;
  if (do_knorm) { bf16_t* K = (bf16_t*)(ws + O_RA + SZ_LK); const int sub = lane & 15, rsel = lane >> 4;
    const f32x4 w0 = *(const f32x4*)(P.o_k_norm + sub * 8), w1 = *(const f32x4*)(P.o_k_norm + sub * 8 + 4);
    for (int r0 = gw * 16; r0 < L * 8; r0 += ngw * 16) {
      u32x4 w[4];
#pragma unroll
      for (int k = 0; k < 4; ++k) w[k] = *(const u32x4*)(K + (size_t)(r0 + k * 4 + rsel) * 128 + sub * 8);
#pragma unroll
      for (int k = 0; k < 4; ++k) { float v[8]; float ss = 0.f;
#pragma unroll
        for (int e = 0; e < 4; ++e) { v[2 * e] = lo2f(w[k][e]); v[2 * e + 1] = hi2f(w[k][e]); ss += v[2 * e] * v[2 * e] + v[2 * e + 1] * v[2 * e + 1]; }
        ss += __shfl_xor(ss, 1); ss += __shfl_xor(ss, 2); ss += __shfl_xor(ss, 4); ss += __shfl_xor(ss, 8);
        const float rstd = rsqrtf(ss * (1.f / 128.f) + EPS);
        u32x4 o; o[0] = pk2(v[0] * rstd * w0[0], v[1] * rstd * w0[1]); o[1] = pk2(v[2] * rstd * w0[2], v[3] * rstd * w0[3]);
        o[2] = pk2(v[4] * rstd * w1[0], v[5] * rstd * w1[1]); o[3] = pk2(v[6] * rstd * w1[2], v[7] * rstd * w1[3]);
        *(u32x4*)(K + (size_t)(r0 + k * 4 + rsel) * 128 + sub * 8) = o; } } }
  { const bf16_t* xr = (const bf16_t*)(ws + O_XBCR); bf16_t* xc = (bf16_t*)(ws + O_XBCC); bf16_t* xt = (bf16_t*)(ws + O_XBCT);
    bf16_t* RAW = (bf16_t*)(lds + wid * 17920); bf16_t* TS = RAW + 68 * 64;
    for (int it = gw; it < 256 * 24; it += ngw) {
      const int tb = it / 24, cb = it % 24, t0 = tb * 64, ch = cb * 64 + lane;
#pragma unroll
      for (int i = 0; i < 9; ++i) { const int id = lane + 64 * i;
        if (id < 544) { const int r = id >> 3, cc = id & 7, t = t0 - 2 + r; u32x4 v = {0u, 0u, 0u, 0u};
          if (t >= 0 && t < L) v = *(const u32x4*)(xr + (size_t)t * 1536 + cb * 64 + cc * 8);
          *(u32x4*)(RAW + r * 64 + cc * 8) = v; } }
      const float w0 = P.ssd_conv_w[0 * 1536 + ch], w1 = P.ssd_conv_w[1 * 1536 + ch], w2 = P.ssd_conv_w[2 * 1536 + ch], w3 = P.ssd_conv_w[3 * 1536 + ch], w4 = P.ssd_conv_w[4 * 1536 + ch];
      const float cb_ = P.ssd_conv_b[ch];
      WAVE_LDS_FENCE();
      float a0 = bf2f(RAW[0 * 64 + lane]), a1 = bf2f(RAW[1 * 64 + lane]), a2 = bf2f(RAW[2 * 64 + lane]), a3 = bf2f(RAW[3 * 64 + lane]);
#pragma unroll 1
      for (int i0 = 0; i0 < 64; i0 += 8) { float nx[8];
#pragma unroll
        for (int k = 0; k < 8; ++k) nx[k] = bf2f(RAW[(i0 + k + 4) * 64 + lane]);
#pragma unroll
        for (int k = 0; k < 8; ++k) { const float a4 = nx[k];
          const float v = silu_f(w0 * a0 + w1 * a1 + w2 * a2 + w3 * a3 + w4 * a4 + cb_);
          const bf16_t b = f2bf(v); RAW[(i0 + k) * 64 + lane] = b; TS[lane * 72 + i0 + k] = b;
          a0 = a1; a1 = a2; a2 = a3; a3 = a4; } }
      WAVE_LDS_FENCE();
      if (cb >= 16) {
#pragma unroll
        for (int j = 0; j < 8; ++j) { const int id = lane + 64 * j, r = id >> 3, cc = id & 7;
          *(u32x4*)(xc + (size_t)(t0 + r) * 1536 + cb * 64 + cc * 8) = *(const u32x4*)(RAW + r * 64 + cc * 8); } }
      if (cb < 20) {
#pragma unroll
        for (int j = 0; j < 8; ++j) { const int r = (lane >> 3) + 8 * j, cc = lane & 7;
          *(u32x4*)(xt + (size_t)(cb * 64 + r) * L + t0 + cc * 8) = *(const u32x4*)(TS + r * 72 + cc * 8); } }
      WAVE_LDS_FENCE();
    } }
  { const float* dtr = (const float*)(ws + O_DTR); float* dt = (float*)(ws + O_DT); float* cum = (float*)(ws + O_CUM); float* tot = (float*)(ws + O_TOT);
    __syncthreads();
    float* A = (float*)(lds + wid * 16896);
    for (int c = gw; c < NCH; c += ngw) {
      const int col4 = (lane & 7) * 4; f32x4 bb, aa;
#pragma unroll
      for (int e = 0; e < 4; ++e) { bb[e] = P.ssd_dt_bias[col4 + e]; aa[e] = -__expf(P.ssd_a_log[col4 + e]); }
#pragma unroll 4
      for (int i = 0; i < 16; ++i) { const int t = i * 8 + (lane >> 3);
        const f32x4 v = *(const f32x4*)(dtr + ((size_t)c * 128 + t) * 32 + col4); f32x4 d;
#pragma unroll
        for (int e = 0; e < 4; ++e) { const float x = v[e] + bb[e]; d[e] = x > 20.f ? x : log1pf(__expf(x)); A[t * 33 + col4 + e] = d[e] * aa[e]; }
        *(f32x4*)(dt + ((size_t)c * 128 + t) * 32 + col4) = d; }
      WAVE_LDS_FENCE();
      if (lane < 32) { float cs = 0.f;
#pragma unroll 8
        for (int i = 0; i < 128; ++i) { const int t = lane < 16 ? i : 127 - i; cs += A[t * 33 + lane]; A[t * 33 + lane] = cs; }
        tot[c * 32 + lane] = cs; }
      WAVE_LDS_FENCE();
#pragma unroll 4
      for (int i = 0; i < 16; ++i) { const int t = i * 8 + (lane >> 3); f32x4 o;
#pragma unroll
        for (int e = 0; e < 4; ++e) o[e] = A[t * 33 + col4 + e];
        *(f32x4*)(cum + ((size_t)c * 128 + t) * 32 + col4) = o; }
      WAVE_LDS_FENCE();
    } }
}
__device__ __forceinline__ void ssd1_phase(const Params& P, unsigned char* lds, int bid, int G, int tid, int wid, int lane) {
  unsigned char* ws = P.ws;
  const bf16_t* xt = (const bf16_t*)(ws + O_XBCT); const float* dt = (const float*)(ws + O_DT); const float* cum = (const float*)(ws + O_CUM);
  bf16_t* ST = (bf16_t*)(ws + O_H);
  bf16_t* BT = (bf16_t*)lds; bf16_t* XF = (bf16_t*)(lds + 34816); bf16_t* XB = (bf16_t*)(lds + 34816 + 17408); float* wFa = (float*)(lds + 34816 + 2 * 17408); float* wBa = wFa + 8 * 128;
  for (int u = bid; u < NCH * 2; u += G) {
    const int c = u >> 1, gr = u & 1;
    __syncthreads();
#pragma unroll
    for (int i = 0; i < 4; ++i) { const int ch = tid + 512 * i, r = ch >> 4, cc = ch & 15;
      *(u32x4*)(BT + r * 136 + cc * 8) = *(const u32x4*)(xt + (size_t)(1024 + gr * 128 + r) * L + c * 128 + cc * 8); }
    { const int l = tid & 127, hq = tid >> 7; const size_t t = (size_t)c * 128 + l;
#pragma unroll
      for (int k = 0; k < 2; ++k) { const int hh = hq + 4 * k, h = gr * 8 + hh;
        wFa[hh * 128 + l] = dt[t * 32 + h] * __expf(cum[((size_t)c * 128 + 127) * 32 + h] - cum[t * 32 + h]);
        wBa[hh * 128 + l] = dt[t * 32 + 16 + h] * __expf(cum[((size_t)c * 128) * 32 + 16 + h] - cum[t * 32 + 16 + h]); } }
    __syncthreads();
    u32x4 wx[2];
#pragma unroll
    for (int i = 0; i < 2; ++i) { const int ch = tid + 512 * i, r = ch >> 4, cc = ch & 15; wx[i] = *(const u32x4*)(xt + (size_t)(gr * 8 * 64 + r) * L + c * 128 + cc * 8); }
#pragma unroll 1
    for (int hh = 0; hh < 8; ++hh) {
      const int h = gr * 8 + hh;
      const float* wF = wFa + hh * 128; const float* wB = wBa + hh * 128;
#pragma unroll
      for (int i = 0; i < 2; ++i) { const int ch = tid + 512 * i, r = ch >> 4, cc = ch & 15;
        const u32x4 w = wx[i];
        u32x4 of, ob;
#pragma unroll
        for (int e = 0; e < 4; ++e) { const float x0 = lo2f(w[e]), x1 = hi2f(w[e]); const int l0 = cc * 8 + 2 * e;
          of[e] = pk2(x0 * wF[l0], x1 * wF[l0 + 1]); ob[e] = pk2(x0 * wB[l0], x1 * wB[l0 + 1]); }
        *(u32x4*)(XF + r * 136 + cc * 8) = of; *(u32x4*)(XB + r * 136 + cc * 8) = ob; }
      __syncthreads();
      if (hh + 1 < 8) {
#pragma unroll
        for (int i = 0; i < 2; ++i) { const int ch = tid + 512 * i, r = ch >> 4, cc = ch & 15; wx[i] = *(const u32x4*)(xt + (size_t)((h + 1) * 64 + r) * L + c * 128 + cc * 8); } }
      { const int dir = wid >> 2, pt = wid & 3; const bf16_t* XS = dir ? XB : XF;
        f32x4 acc[8];
#pragma unroll
        for (int i = 0; i < 8; ++i) acc[i] = (f32x4){0.f, 0.f, 0.f, 0.f};
#pragma unroll
        for (int ks = 0; ks < 4; ++ks) { const bf16x8 a = ldfrag(XS, 136, 16 * pt, ks * 32, lane); bf16x8 bb[8];
#pragma unroll
          for (int nt = 0; nt < 8; ++nt) bb[nt] = ldfrag(BT, 136, 16 * nt, ks * 32, lane);
#pragma unroll
          for (int nt = 0; nt < 8; ++nt) acc[nt] = mfma16(a, bb[nt], acc[nt]); }
        bf16_t* dst = ST + (((size_t)c * 16 + h) * 2 + dir) * 8192;
#pragma unroll
        for (int nt = 0; nt < 8; ++nt)
#pragma unroll
          for (int r = 0; r < 4; ++r) dst[(16 * pt + (lane >> 4) * 4 + r) * 128 + 16 * nt + (lane & 15)] = f2bf(acc[nt][r]); }
      __syncthreads();
    }
  }
}
__device__ __forceinline__ void ssd_carry_phase(const Params& P, int bid, int G, int tid) {
  bf16_t* ST = (bf16_t*)(P.ws + O_H); const float* tot = (const float*)(P.ws + O_TOT);
  for (int e2 = bid * 512 + tid; e2 < 16 * 2 * 8192 / 2; e2 += G * 512) {
    const int e = e2 * 2, h = e >> 14, dir = (e >> 13) & 1;
    float r0 = 0.f, r1 = 0.f;
#pragma unroll 1
    for (int ib = 0; ib < NCH; ib += 16) {
      unsigned w[16]; float dec[16];
#pragma unroll
      for (int k = 0; k < 16; ++k) { const int c = dir ? NCH - 1 - (ib + k) : ib + k;
        w[k] = *(const unsigned*)(ST + (size_t)c * 262144 + e); dec[k] = tot[c * 32 + dir * 16 + h]; }
#pragma unroll
      for (int k = 0; k < 16; ++k) { const int c = dir ? NCH - 1 - (ib + k) : ib + k;
        *(unsigned*)(ST + (size_t)c * 262144 + e) = pk2(r0, r1);
        const float d = __expf(dec[k]); r0 = r0 * d + lo2f(w[k]); r1 = r1 * d + hi2f(w[k]); }
    }
  }
}
__device__ __forceinline__ void ssd2_phase(const Params& P, unsigned char* lds, int bid, int G, int tid, int wid, int lane) {
  unsigned char* ws = P.ws;
  const bf16_t* xc = (const bf16_t*)(ws + O_XBCC); const bf16_t* xt = (const bf16_t*)(ws + O_XBCT); const bf16_t* zs = (const bf16_t*)(ws + O_ZS);
  const float* dt = (const float*)(ws + O_DT); const float* cum = (const float*)(ws + O_CUM); const bf16_t* ST = (const bf16_t*)(ws + O_H);
  bf16_t* oc = (bf16_t*)(ws + O_OA); float* ssq = (float*)(ws + O_SSQ);
  bf16_t* Cs = (bf16_t*)lds; bf16_t* Bs = (bf16_t*)(lds + 34816); bf16_t* XT = (bf16_t*)(lds + 2 * 34816); bf16_t* Sf = (bf16_t*)(lds + 2 * 34816 + 17408);
  bf16_t* Sb = (bf16_t*)(lds + 2 * 34816 + 2 * 17408); float* cF = (float*)(lds + 2 * 34816 + 3 * 17408); float* dF = cF + 128; float* cB = cF + 256; float* dB = cF + 384;
  bf16_t* ZT = (bf16_t*)(lds + 2 * 34816 + 3 * 17408 + 2048);
  bf16_t* Ms = Bs + wid * 16 * 136;
  const int n = lane & 15, kq = lane >> 4;
  for (int u = bid; u < NCH * 2; u += G) {
    const int c = u >> 1, gr = u & 1;
    __syncthreads();
#pragma unroll
    for (int i = 0; i < 4; ++i) { const int ch = tid + 512 * i, r = ch >> 4, cc = ch & 15; const size_t t = (size_t)c * 128 + r;
      *(u32x4*)(Bs + r * 136 + cc * 8) = *(const u32x4*)(xc + t * 1536 + 1024 + gr * 128 + cc * 8);
      *(u32x4*)(Cs + r * 136 + cc * 8) = *(const u32x4*)(xc + t * 1536 + 1280 + gr * 128 + cc * 8); }
    __syncthreads();
    bf16x8 ca[4]; f32x4 gacc[8];
#pragma unroll
    for (int ks = 0; ks < 4; ++ks) ca[ks] = ldfrag(Cs, 136, 16 * wid, ks * 32, lane);
#pragma unroll
    for (int tc = 0; tc < 8; ++tc) { gacc[tc] = (f32x4){0.f, 0.f, 0.f, 0.f};
#pragma unroll
      for (int ks = 0; ks < 4; ++ks) gacc[tc] = mfma16(ca[ks], ldfrag(Bs, 136, 16 * tc, ks * 32, lane), gacc[tc]); }
    u32x4 px[2], pf[2], pb[2], pz[2]; float pc0 = 0.f, pc1 = 0.f, pc2 = 0.f, pc3 = 0.f;
    float sqh[4] = {0.f, 0.f, 0.f, 0.f};
#define SSD2_FETCH(H) do { _Pragma("unroll") for (int i = 0; i < 2; ++i) { const int ch = tid + 512 * i, r = ch >> 4, cc = ch & 15; \
        px[i] = *(const u32x4*)(xt + (size_t)((H) * 64 + r) * L + c * 128 + cc * 8); \
        pf[i] = *(const u32x4*)(ST + (((size_t)c * 16 + (H)) * 2 + 0) * 8192 + r * 128 + cc * 8); \
        pb[i] = *(const u32x4*)(ST + (((size_t)c * 16 + (H)) * 2 + 1) * 8192 + r * 128 + cc * 8); \
        pz[i] = *(const u32x4*)(zs + ((size_t)c * 128 + (ch >> 3)) * 1024 + (H) * 64 + (ch & 7) * 8); } \
      if (tid < 128) { const size_t t = (size_t)c * 128 + tid; pc0 = cum[t * 32 + (H)]; pc1 = dt[t * 32 + (H)]; pc2 = cum[t * 32 + 16 + (H)]; pc3 = dt[t * 32 + 16 + (H)]; } } while (0)
    SSD2_FETCH(gr * 8);
#pragma unroll 1
    for (int hh = 0; hh < 8; ++hh) {
      const int h = gr * 8 + hh;
      __syncthreads();
#pragma unroll
      for (int i = 0; i < 2; ++i) { const int ch = tid + 512 * i, r = ch >> 4, cc = ch & 15;
        *(u32x4*)(XT + r * 136 + cc * 8) = px[i]; *(u32x4*)(Sf + r * 136 + cc * 8) = pf[i]; *(u32x4*)(Sb + r * 136 + cc * 8) = pb[i];
        *(u32x4*)(ZT + (ch >> 3) * 72 + (ch & 7) * 8) = pz[i]; }
      if (tid < 128) { cF[tid] = pc0; dF[tid] = pc1; cB[tid] = pc2; dB[tid] = pc3; }
      __syncthreads();
      if (hh + 1 < 8) SSD2_FETCH(h + 1);
      f32x4 yacc[4];
#pragma unroll
      for (int i = 0; i < 4; ++i) yacc[i] = (f32x4){0.f, 0.f, 0.f, 0.f};
#pragma unroll 1
      for (int dir = 0; dir < 2; ++dir) {
        const float* cu = dir ? cB : cF; const float* dd = dir ? dB : dF; const bf16_t* S = dir ? Sb : Sf;
        int nn = n; asm volatile("" : "+v"(nn));
        float cl[4];
#pragma unroll
        for (int r = 0; r < 4; ++r) cl[r] = cu[16 * wid + kq * 4 + r];
        float cs8[8], ds8[8];
#pragma unroll
        for (int tc = 0; tc < 8; ++tc) { cs8[tc] = cu[16 * tc + n]; ds8[tc] = dd[16 * tc + n]; }
#pragma unroll
        for (int tc = 0; tc < 8; ++tc) { const int s_ = 16 * tc + n; const int rel = tc - wid;
          const bool full = dir ? (rel > 0) : (rel < 0);
          if (full || rel == 0) { const float cs_ = cs8[tc], ds_ = ds8[tc];
#pragma unroll
            for (int r = 0; r < 4; ++r) {
              float v = gacc[tc][r] * __expf(cl[r] - cs_) * ds_;
              if (!full) { const bool ok = dir ? (nn >= kq * 4 + r) : (nn <= kq * 4 + r); v = ok ? v : 0.f; }
              Ms[(kq * 4 + r) * 136 + s_] = f2bf(v); }
          } else {
#pragma unroll
            for (int r = 0; r < 4; ++r) Ms[(kq * 4 + r) * 136 + s_] = 0; } }
        WAVE_LDS_FENCE();
        f32x4 oacc[4];
#pragma unroll
        for (int pt = 0; pt < 4; ++pt) oacc[pt] = (f32x4){0.f, 0.f, 0.f, 0.f};
#pragma unroll
        for (int ks = 0; ks < 4; ++ks) { const bf16x8 ma = ldfrag(Ms, 136, 0, ks * 32, lane);
#pragma unroll
          for (int pt = 0; pt < 4; ++pt) { yacc[pt] = mfma16(ma, ldfrag(XT, 136, 16 * pt, ks * 32, lane), yacc[pt]);
            oacc[pt] = mfma16(ca[ks], ldfrag(S, 136, 16 * pt, ks * 32, lane), oacc[pt]); } }
        WAVE_LDS_FENCE();
#pragma unroll
        for (int r = 0; r < 4; ++r) { const float ed = __expf(cl[r]);
#pragma unroll
          for (int pt = 0; pt < 4; ++pt) yacc[pt][r] += oacc[pt][r] * ed; }
      }
      const float Dh = P.ssd_d[h];
#pragma unroll
      for (int r = 0; r < 4; ++r) { const size_t t = (size_t)c * 128 + 16 * wid + kq * 4 + r; float sq = 0.f;
#pragma unroll
        for (int pt = 0; pt < 4; ++pt) { const int col = h * 64 + 16 * pt + n;
          const int l_ = 16 * wid + kq * 4 + r, p_ = 16 * pt + n;
          const float y = (yacc[pt][r] + Dh * bf2f(XT[p_ * 136 + l_])) * bf2f(ZT[l_ * 72 + p_]);
          oc[t * 2048 + col] = f2bf(y); sq += y * y; }
        sq += __shfl_xor(sq, 1); sq += __shfl_xor(sq, 2); sq += __shfl_xor(sq, 4); sq += __shfl_xor(sq, 8);
        sqh[r] += sq; }
    }
    if (n == 0) {
#pragma unroll
      for (int r = 0; r < 4; ++r) ssq[((size_t)c * 128 + 16 * wid + kq * 4 + r) * 2 + gr] = sqh[r]; }
  }
}
#undef SSD2_FETCH
#ifndef SDG
#define SDG 2
#endif
#ifndef SDN
#define SDN 1
#endif
#ifndef PHG
#define PHG 0x1F
#endif
#ifndef GAL_SPLIT
#define GAL_SPLIT true
#endif
#ifndef GAL_GLU
#define GAL_GLU true
#endif
#ifndef GAL_RES
#define GAL_RES true
#endif
#ifndef GQA_HMAJOR
#define GQA_HMAJOR 1
#endif
#ifndef DUP
#define DUP 0
#endif
#define REP(k) for (int rep_ = 0; rep_ <= ((DUP >> (k)) & 1); ++rep_)
#define RSYNC if (rep_) __syncthreads();
#ifndef PH
#define PH 0xFFFF
#endif
__device__ __forceinline__ void gbar(unsigned* ctr, unsigned target, int tid) {
  __builtin_amdgcn_fence(__ATOMIC_RELEASE, "agent");
  asm volatile("s_waitcnt vmcnt(0) lgkmcnt(0)" ::: "memory");
  __syncthreads();
  if (tid == 0) {
    __hip_atomic_fetch_add(ctr, 1u, __ATOMIC_RELAXED, __HIP_MEMORY_SCOPE_AGENT);
    while (__hip_atomic_load(ctr, __ATOMIC_RELAXED, __HIP_MEMORY_SCOPE_AGENT) < target) __builtin_amdgcn_s_sleep(2);
  }
  __syncthreads();
  __builtin_amdgcn_fence(__ATOMIC_ACQUIRE, "agent");
  asm volatile("s_waitcnt vmcnt(0)" ::: "memory");
}
__device__ __forceinline__ Params load_params() {
#if defined(__HIP_DEVICE_COMPILE__)
  const __attribute__((address_space(4))) Params* pp = (const __attribute__((address_space(4))) Params*)__builtin_amdgcn_kernarg_segment_ptr();
  asm volatile("" : "+s"(pp));
  return *pp;
#else
  return Params{};
#endif
}
#define XB_TMO      128
#define XB_XCNT(j)  (256  + 64 * (j))
#define XB_XSUB(j)  (1280 + 64 * (j))
#define XB_XGEN(j)  (2304 + 64 * (j))
#define XB_TOP      3328
#define XB_TOPGEN   3392
#define XCD_BAR_WORDS 3456
#define XB_SPIN_CAP (1u << 18)
#define XB_LAS __attribute__((address_space(3)))
__device__ __forceinline__ unsigned xb_ld(unsigned* p)              { return __hip_atomic_load(p, __ATOMIC_RELAXED, __HIP_MEMORY_SCOPE_AGENT); }
__device__ __forceinline__ unsigned xb_add(unsigned* p, unsigned v) { return __hip_atomic_fetch_add(p, v, __ATOMIC_RELAXED, __HIP_MEMORY_SCOPE_AGENT); }
__device__ __forceinline__ unsigned xb_xcc_id() { return (unsigned)__builtin_amdgcn_s_getreg((3 << 11) | 20) & 0xFu; }
#define XB_SPIN(cond, bar) do { unsigned _sp = 0; while (cond) { __builtin_amdgcn_s_sleep(1); \
    if ((++_sp & 255u) == 0u) { if (xb_ld(&(bar)[XB_TMO])) break; if (_sp > XB_SPIN_CAP) { atomicAdd(&(bar)[XB_TMO], 1u); break; } } } } while (0)
struct XcdBarrier { unsigned* bar; unsigned x; volatile XB_LAS unsigned* st; };
__device__ __forceinline__ XcdBarrier xcd_barrier_post(unsigned* bar, volatile XB_LAS unsigned* st, int tid) {
  XcdBarrier b; b.bar = bar; b.x = xb_xcc_id(); b.st = st;
  if (tid == 0) (void)xb_add(&bar[XB_XCNT(b.x)], 1u);
  return b;
}
__device__ __forceinline__ void xcd_barrier_complete(unsigned* bar, unsigned x, unsigned& nloc, unsigned& nx, unsigned G) {
  unsigned sum, cnt, mine, sp = 0u;
  for (;;) {
    sum = 0u; cnt = 0u; mine = 0u;
#pragma unroll
    for (unsigned j = 0; j < 16; ++j) { const unsigned c = xb_ld(&bar[XB_XCNT(j)]); sum += c; cnt += (c > 0u) ? 1u : 0u; mine = (j == x) ? c : mine; }
    if (sum == G) break;
    __builtin_amdgcn_s_sleep(1);
    if ((++sp & 255u) == 0u) { if (xb_ld(&bar[XB_TMO])) break; if (sp > XB_SPIN_CAP) { atomicAdd(&bar[XB_TMO], 1u); break; } }
  }
  nloc = mine > 0u ? mine : 1u; nx = cnt > 0u ? cnt : 1u;
}
__device__ __forceinline__ void xcd_barrier(const XcdBarrier& b, int tid, unsigned G) {
  asm volatile("s_waitcnt vmcnt(0)" ::: "memory");
  __syncthreads();
  if (tid == 0) {
    unsigned* bar = b.bar;
    __builtin_amdgcn_s_waitcnt(0);
    unsigned nloc = b.st[0], nx = b.st[1];
    if (nloc == 0u) { xcd_barrier_complete(bar, b.x, nloc, nx, G); b.st[0] = nloc; b.st[1] = nx; }
    const unsigned old = xb_add(&bar[XB_XSUB(b.x)], 1u);
    const unsigned gen = old / nloc;
    if (old + 1u == (gen + 1u) * nloc) {
      __builtin_amdgcn_fence(__ATOMIC_RELEASE, "agent");
      asm volatile("s_waitcnt vmcnt(0)" ::: "memory");
      const unsigned og = xb_add(&bar[XB_TOP], 1u);
      const unsigned tg = og / nx;
      if (og + 1u == (tg + 1u) * nx) xb_add(&bar[XB_TOPGEN], 1u);
      else XB_SPIN(xb_ld(&bar[XB_TOPGEN]) == tg, bar);
      __builtin_amdgcn_fence(__ATOMIC_ACQUIRE, "agent");
      xb_add(&bar[XB_XGEN(b.x)], 1u);
      asm volatile("s_waitcnt vmcnt(0)" ::: "memory");
    } else {
      XB_SPIN(xb_ld(&bar[XB_XGEN(b.x)]) == gen, bar);
      __builtin_amdgcn_fence(__ATOMIC_ACQUIRE, "agent");
      asm volatile("s_waitcnt vmcnt(0)" ::: "memory");
    }
  }
  __syncthreads();
}
constexpr int LDS_BYTES = 147456;
__global__ __launch_bounds__(512, 2) void mega_fwd(Params Parg) {
  extern __shared__ __attribute__((aligned(16))) unsigned char shm[];
  cg::grid_group grid = cg::this_grid();
  const int G = gridDim.x, bid = blockIdx.x, ngw = G * 8;
  const int wid_s = __builtin_amdgcn_readfirstlane((int)threadIdx.x >> 6);
#define IDS unsigned z_ = 0u; asm volatile("" : "+v"(z_)); int tid_ = wid_s * 64 + (int)__builtin_amdgcn_mbcnt_hi(~0u, __builtin_amdgcn_mbcnt_lo(~0u, z_)); asm volatile("" : "+v"(tid_)); const int tid = tid_, wid = __builtin_amdgcn_readfirstlane(tid >> 6), lane = tid & 63, gw = bid * 8 + wid; (void)lane; (void)gw; (void)wid; \
  const Params P = load_params(); unsigned char* ws = P.ws; (void)ws; \
  const float* mod0 = (const float*)(ws + O_MOD); const float* mod1 = mod0 + 6144; (void)mod0; (void)mod1;
  PG8_LAS unsigned char* glds = (PG8_LAS unsigned char*)shm;
  unsigned* xbar = (unsigned*)(Parg.ws + O_BAR);
  volatile XB_LAS unsigned* xst = (volatile XB_LAS unsigned*)(shm + 147440);
  if (threadIdx.x == 0) { xst[0] = 0u; xst[1] = 0u; }
  if (bid == 0) { for (int i = threadIdx.x; i < XCD_BAR_WORDS; i += 512) xbar[i] = 0u; }
  XcdBarrier xbs; xbs.bar = xbar; xbs.x = 0u; xbs.st = xst;
#define GBAR { IDS; xcd_barrier(xbs, tid, (unsigned)G); }
  REP(0) { RSYNC if (PH & (1 << 0)) {  { IDS; p0_phase(P, shm, bid, G, tid, wid, lane); } } }
  grid.sync();
  { IDS; xbs = xcd_barrier_post(xbar, xst, tid); }
  REP(1) { RSYNC if (PH & (1 << 1)) {  { IDS; norm_mod_phase(P.x, P.e_norm_g, mod0, (bf16_t*)(ws + O_H), gw, ngw, lane); } } }
  GBAR
  if (DUP & (1 << 14)) { for (int xb = 0; xb < 10; ++xb) GBAR }
  REP(2) if ((PH & (1 << 5)) && (PHG & (1 << 0))) { IDS; pg8::Gemm g{(const bf16_t*)(ws + O_H), (const bf16_t*)(ws + O_WT_IN_E), L, 4608, 2048}; pg8::StaticOrder S; S.init(L, 4608, G, bid);
    pg8::EpiSplit E{ws, 0}; pg8::gemm_phase<pg8::EpiSplit, pg8::StaticOrder, GAL_SPLIT, true>(glds, g, S, E, tid); }
  { IDS; const int rem = 1152 % G, first = rem ? rem : 0;
    if (bid >= first) gemm_tail_fill(P, shm, (bid - first) * 8 + wid, (G - first) * 8, wid, lane); }
  GBAR
  REP(3) { RSYNC if (PH & (1 << 2)) {  { IDS; kprep_gqa_phase(P, gw, ngw, lane); } }
  if (PH & (1 << 3)) {  { IDS; s5_phase<false>(P, shm, gw, ngw, wid, lane); } } }
  GBAR
  { IDS; s5_carry_phase(P, bid, G, wid, lane); }
  GBAR
  REP(4) { RSYNC if (PH & (1 << 4)) {  { IDS; s5_phase<true>(P, shm, gw, ngw, wid, lane); } } }
  GBAR
  REP(5) if (PH & (1 << 6)) for (int u = bid; u < 512; u += G) {
    IDS; const int h = GQA_HMAJOR ? (u >> 6) : (u & 7), qb = GQA_HMAJOR ? (u & 63) : (u >> 3), kvh = h >> 2; const size_t tok0 = (size_t)qb * 256;
    __syncthreads();
    attn_body<0, 1024, 256, 2048, SDG>((const bf16_t*)(ws + O_RA) + tok0 * 1024 + h * 128, (const bf16_t*)(ws + O_KN) + kvh * 128, (const bf16_t*)(ws + O_V0) + kvh * 128,
                                  (const bf16_t*)(ws + O_RA + SZ_LK) + tok0 * 1024 + h * 128, (bf16_t*)(ws + O_OA) + tok0 * 2048 + h * 128, P.e_q_norm, L / 64, (int)tok0, 0, 0, (char*)shm, tid);
  }
  __syncthreads();
  REP(6) if ((PH & (1 << 5)) && (PHG & (1 << 1))) { IDS; pg8::Gemm g{(const bf16_t*)(ws + O_Y), (const bf16_t*)(ws + O_WT_GLU), L, 2048, 1024}; pg8::StaticOrder S; S.init(L, 2048, G, bid);
    pg8::EpiGlu E{ws, P.s5_b_glu}; pg8::gemm_phase<pg8::EpiGlu, pg8::StaticOrder, GAL_GLU, true>(glds, g, S, E, tid); }
  GBAR
  REP(7) if ((PH & (1 << 5)) && (PHG & (1 << 2))) { IDS; pg8::Gemm g{(const bf16_t*)(ws + O_OA), (const bf16_t*)(ws + O_WT_OUT_E), L, 2048, 2048}; pg8::StaticOrder S; S.init(L, 2048, G, bid);
    pg8::EpiResX E{P.x, P.out, mod0 + 4096, (bf16_t*)(ws + O_H), (float*)(ws + O_SSQ1)}; pg8::gemm_phase<pg8::EpiResX, pg8::StaticOrder, GAL_RES, true>(glds, g, S, E, tid); }
  GBAR
  REP(9) if ((PH & (1 << 5)) && (PHG & (1 << 3))) { IDS; pg8::Gemm g{(const bf16_t*)(ws + O_H), (const bf16_t*)(ws + O_WT_IN_O), L, 6912, 2048}; pg8::StaticOrder S; S.init(L, 6912, G, bid);
    pg8::EpiSplit E{ws, 1}; pg8::gemm_phase<pg8::EpiSplit, pg8::StaticOrder, GAL_SPLIT, true>(glds, g, S, E, tid); }
  GBAR
  REP(10) { RSYNC if (PH & (1 << 8)) {  { IDS; prep1_phase(P, shm, gw, ngw, wid, lane, rep_ == 0); } } }
  GBAR
  REP(11) if (PH & (1 << 7)) for (int u = bid; u < 512; u += G) {
    IDS; const int h = u >> 6, rg = u & 63, r0 = rg * 4, t0 = min(max(r0 - 4, 0), 244); const size_t tok0 = (size_t)rg * 256;
    __syncthreads();
    { if (tid < 465) ((float*)(shm + SHM_ATTN))[64 + tid] = P.na_rpb[h * 465 + tid] * (1.f / SCALE); }
    attn_body<1, 1024, 1024, 2048, SDN>((const bf16_t*)(ws + O_RA) + tok0 * 1024 + h * 128, (const bf16_t*)(ws + O_RA + SZ_LK) + (size_t)t0 * 64 * 1024 + h * 128,
                                   (const bf16_t*)(ws + O_RA + 2 * SZ_LK) + (size_t)t0 * 64 * 1024 + h * 128, (const bf16_t*)(ws + O_RA + 3 * SZ_LK) + tok0 * 1024 + h * 128,
                                   (bf16_t*)(ws + O_OA) + tok0 * 2048 + 1024 + h * 128, P.o_q_norm, 12, (int)tok0, r0, t0, (char*)shm, tid);
  }
  REP(12) { RSYNC if (PH & (1 << 10)) {  { IDS; ssd1_phase(P, shm, bid, G, tid, wid, lane); } } }
  GBAR
  if (PH & (1 << 11)) {  { IDS; ssd_carry_phase(P, bid, G, tid); } }
  GBAR
  REP(13) { RSYNC if (PH & (1 << 12)) {  { IDS; ssd2_phase(P, shm, bid, G, tid, wid, lane); } } }
  GBAR
  if ((PH & (1 << 5)) && (PHG & (1 << 4))) { IDS; pg8::Gemm g{(const bf16_t*)(ws + O_OA), (const bf16_t*)(ws + O_WT_OUT_O), L, 2048, 2048}; pg8::StaticOrder S; S.init(L, 2048, G, bid);
    pg8::EpiResScale E{P.out, P.out, mod1 + 4096, (const float*)(ws + O_SSQ)}; pg8::gemm_phase<pg8::EpiResScale, pg8::StaticOrder, GAL_RES, true>(glds, g, S, E, tid); }
}

extern "C" void kernel_launch(void* const* d_in, const int* in_sizes, int n_in, void* d_out, int out_size, void* d_ws, size_t ws_size, hipStream_t stream) {
  static int grid_blocks = 0;
  if (grid_blocks == 0) {
    if (n_in != 33 || out_size != L * DM || ws_size < WS_END) { fprintf(stderr, "kernel_launch: unexpected shapes: n_in %d out %d ws %zu (need %zu)\n", n_in, out_size, ws_size, (size_t)WS_END); grid_blocks = -1; return; }
    int dev = 0, cus = 0, per_cu = 0;
    if (hipGetDevice(&dev) != hipSuccess || hipDeviceGetAttribute(&cus, hipDeviceAttributeMultiprocessorCount, dev) != hipSuccess) { grid_blocks = -1; return; }
    if (hipFuncSetAttribute((const void*)mega_fwd, hipFuncAttributeMaxDynamicSharedMemorySize, LDS_BYTES) != hipSuccess) { fprintf(stderr, "kernel_launch: hipFuncSetAttribute failed\n"); grid_blocks = -1; return; }
    if (hipOccupancyMaxActiveBlocksPerMultiprocessor(&per_cu, (const void*)mega_fwd, 512, LDS_BYTES) != hipSuccess || per_cu < 1) { fprintf(stderr, "kernel_launch: occupancy query says %d\n", per_cu); per_cu = 1; }
    (void)hipGetLastError();
    grid_blocks = cus;
  }
  if (grid_blocks < 0) return;
  Params p{};
  const float** pf = (const float**)&p;
  for (int i = 0; i < 33; ++i) pf[i] = (const float*)d_in[i];
  p.out = (float*)d_out; p.ws = (unsigned char*)d_ws;
  void* args[] = {&p};
  hipError_t e = hipLaunchCooperativeKernel((const void*)mega_fwd, dim3(grid_blocks), dim3(512), args, LDS_BYTES, stream);
  if (e != hipSuccess) fprintf(stderr, "cooperative launch failed: %s (grid %d)\n", hipGetErrorString(e), grid_blocks);
}
```

```cpp
#include <hip/hip_runtime.h>
#include <hip/hip_cooperative_groups.h>
#include <cstdio>
#include <cstdint>
namespace cg = cooperative_groups;

typedef unsigned short bf16_t;
using bf16x8 = __attribute__((ext_vector_type(8))) short;
using s16x4  = __attribute__((ext_vector_type(4))) short;
using f32x16 = __attribute__((ext_vector_type(16))) float;
using f32x8  = __attribute__((ext_vector_type(8))) float;
using f32x4  = __attribute__((ext_vector_type(4))) float;
using u32x4  = __attribute__((ext_vector_type(4))) unsigned;
using u32x2  = __attribute__((ext_vector_type(2))) unsigned;

constexpr int L = 16384, DM = 2048, NCH = 128;
constexpr float SCALE = 0.088388347648318440f;
constexpr float THR = 8.f;
constexpr float EPS = 1e-6f;

constexpr size_t SZ_LK  = (size_t)L * 1024 * 2;
constexpr size_t O_WT_IN_E = 0;
constexpr size_t O_WT_GLU  = O_WT_IN_E + (size_t)4608 * 2048 * 2;
constexpr size_t O_WT_IN_O = O_WT_GLU + (size_t)2048 * 1024 * 2;
constexpr size_t O_XBCT    = 0;
constexpr size_t O_WT_OUT_E = O_WT_IN_O + (size_t)6912 * 2048 * 2;
constexpr size_t O_WT_OUT_O = O_WT_OUT_E + (size_t)2048 * 2048 * 2;
constexpr size_t O_MOD  = O_WT_OUT_O + (size_t)2048 * 2048 * 2;
constexpr size_t O_BBAR = O_MOD + 2 * 6144 * 4;
constexpr size_t O_CMAT = O_BBAR + 2 * 64 * 128 * 16 * 2;
constexpr size_t O_AB   = O_CMAT + 2 * 64 * 16 * 128 * 2;
constexpr size_t O_H    = O_AB + 2 * 64 * 64 * 2 * 4;
constexpr size_t O_RA   = O_H + (size_t)L * 2048 * 2;
constexpr size_t O_RB   = O_RA + 4 * SZ_LK;
constexpr size_t O_KR   = O_RB;
constexpr size_t O_KN   = O_KR + (size_t)L * 256 * 2;
constexpr size_t O_V0   = O_KN + (size_t)L * 256 * 2;
constexpr size_t O_S5E  = O_V0 + (size_t)L * 256 * 2;
constexpr size_t O_ZS   = O_RB;
constexpr size_t O_XBCR = O_ZS + SZ_LK;
constexpr size_t O_XBCC = O_XBCR + (size_t)L * 1536 * 2;
constexpr size_t O_DTR  = O_XBCC + (size_t)L * 1536 * 2;
constexpr size_t O_DT   = O_DTR + (size_t)L * 32 * 4;
constexpr size_t O_CUM  = O_DT + (size_t)L * 32 * 4;
constexpr size_t O_TOT  = O_CUM + (size_t)L * 32 * 4;
constexpr size_t O_SSQ  = O_TOT + 128 * 32 * 4;
constexpr size_t O_RB_END = O_SSQ + (size_t)L * 16 * 4;
constexpr size_t O_OA   = O_RB_END;
constexpr size_t O_Y    = O_OA + (size_t)L * 2048 * 2;
constexpr size_t O_BAR  = O_Y + SZ_LK;
constexpr size_t O_SSQ1 = O_BAR + 16384;
constexpr size_t O_SWO  = O_SSQ1 + (size_t)L * 4;
constexpr size_t WS_END = O_SWO + 32768;
static_assert(O_XBCT + (size_t)1536 * L * 2 <= O_WT_OUT_E, "xbcT overlay");
static_assert(O_S5E + (size_t)128 * 64 * 2 * 128 * 4 <= O_RB_END, "layer-0 RB");

struct Params {
  const float *x, *c, *e_norm_g, *e_ada_w, *e_ada_b, *e_w_in, *e_q_norm, *e_k_norm, *s5_lam_re, *s5_lam_im, *s5_log_step, *s5_b_re, *s5_b_im,
              *s5_c_re, *s5_c_im, *s5_d, *s5_w_glu, *s5_b_glu, *e_w_out, *o_norm_g, *o_ada_w, *o_ada_b, *o_w_in, *o_q_norm, *o_k_norm, *na_rpb,
              *ssd_conv_w, *ssd_conv_b, *ssd_dt_bias, *ssd_a_log, *ssd_d, *ssd_norm_w, *o_w_out;
  float* out; unsigned char* ws;
};

#define WAVE_LDS_FENCE() asm volatile("s_waitcnt lgkmcnt(0)" ::: "memory")
__device__ __forceinline__ float bf2f(bf16_t b) { return __uint_as_float(((unsigned)b) << 16); }
__device__ __forceinline__ bf16_t f2bf(float f) { unsigned u = __float_as_uint(f); u += 0x7FFFu + ((u >> 16) & 1u); return (bf16_t)(u >> 16); }
__device__ __forceinline__ unsigned pk2(float lo, float hi) { unsigned r; asm volatile("v_cvt_pk_bf16_f32 %0, %1, %2" : "=v"(r) : "v"(lo), "v"(hi)); return r; }
__device__ __forceinline__ float lo2f(unsigned w) { return __uint_as_float(w << 16); }
__device__ __forceinline__ float hi2f(unsigned w) { return __uint_as_float(w & 0xffff0000u); }
__device__ __forceinline__ float silu_f(float v) { return v * __builtin_amdgcn_rcpf(1.f + __expf(-v)); }
__device__ __forceinline__ float sigmoid_f(float v) { return __builtin_amdgcn_rcpf(1.f + __expf(-v)); }
__device__ __forceinline__ float wave_sum(float v) {
#pragma unroll
  for (int o = 1; o < 64; o <<= 1) v += __shfl_xor(v, o);
  return v;
}
__device__ __forceinline__ void sincos_rev(float ang, float& s, float& c) {
  float rev = ang * 0.15915494309189535f; rev -= floorf(rev);
  s = __builtin_amdgcn_sinf(rev); c = __builtin_amdgcn_cosf(rev);
}
__device__ __forceinline__ f32x4 mfma16(bf16x8 a, bf16x8 b, f32x4 c) { return __builtin_amdgcn_mfma_f32_16x16x32_bf16(a, b, c, 0, 0, 0); }
__device__ __forceinline__ bf16x8 ldfrag(const bf16_t* base, int ld, int r0, int k0, int lane) {
  return *reinterpret_cast<const bf16x8*>(base + (r0 + (lane & 15)) * ld + k0 + (lane >> 4) * 8);
}
namespace pg8 {
#define PG8_LAS __attribute__((address_space(3)))
typedef unsigned short bf16_t;
typedef short bf16x8 __attribute__((ext_vector_type(8)));
typedef float f32x4 __attribute__((ext_vector_type(4)));
typedef unsigned u32x4 __attribute__((ext_vector_type(4)));
constexpr int BM = 256, BK = 64, HALF = 128, HTB = HALF * BK * 2  , STAGE_BYTES = 8 * HTB, NXCD = 8, WGM = 8;

__host__ __device__ __forceinline__ int lds_byte(int r, int c) { const int st = (r >> 4) * 2 + (c >> 5), rr = r & 15, cc = c & 31, ob = rr * 64 + cc * 2; return st * 1024 + (ob ^ (((ob >> 9) & 1) << 5)); }
__host__ __device__ __forceinline__ void stage_rc(int b, int& R, int& C) { const int st = b / 1024, sb = b % 1024, swz = sb ^ (((sb >> 9) & 1) << 5); R = (st >> 1) * 16 + swz / 64; C = (st & 1) * 32 + (swz % 64) / 2; }
__host__ __device__ __forceinline__ int perm32(int rho) { const int n = rho >> 4, i = rho & 15; return 8 * (i >> 2) + 4 * n + (i & 3); }

struct Unit { int pm, pn; };
struct Gemm { const bf16_t* A; const bf16_t* Bt; int M, N, K; };

struct StaticOrder {
    int nM, nN, nwg, G, c;
    __host__ __device__ void init(int M, int N, int G_, int c_) { nM = M / BM; nN = N / BM; nwg = nM * nN; G = G_; c = c_; }
    __host__ __device__ bool next(int i, Unit& u) const {
        const long L = (long)i * G + c; if (L >= nwg) return false;
        int wgid = (int)L; { const int q = nwg / NXCD, r = nwg % NXCD, xcd = wgid % NXCD, off = wgid / NXCD; wgid = (xcd < r ? xcd * (q + 1) : r * (q + 1) + (xcd - r) * q) + off; }
        const int nig = WGM * nN, gid = wgid / nig, fm = gid * WGM, gsz = (nM - fm) < WGM ? (nM - fm) : WGM;
        u.pm = fm + ((wgid % nig) % gsz); u.pn = (wgid % nig) / gsz; return true;
    }
    __device__ __forceinline__ void a_ready(const Unit&) const {}
    __device__ __forceinline__ void done(const Unit&) const {}
};
__device__ __forceinline__ unsigned cvt_pk_bf16(float lo, float hi) { unsigned r; asm volatile("v_cvt_pk_bf16_f32 %0, %1, %2" : "=v"(r) : "v"(lo), "v"(hi)); return r; }
template <class Epi, class Sched, bool ALIGN_EPI = false, bool SP2 = false>
__device__ __forceinline__ void gemm_phase(PG8_LAS unsigned char* lds, const Gemm g, const Sched& S, const Epi& E, const int tid) {
    const int wid = __builtin_amdgcn_readfirstlane(tid >> 6), lane = tid & 63, wr = wid >> 2, wc = wid & 3, fr = lane & 15, fq = lane >> 4;
    const int K = g.K, nt = K / BK;
    unsigned voffA[2], voffB[2];
#pragma unroll
    for (int i = 0; i < 2; ++i) { int R, C; stage_rc(tid * 16 + i * 8192, R, C); const int Rb = Epi::PERM ? ((R & ~31) + perm32(R & 31)) : R;
        voffA[i] = (unsigned)(R * K + C) * 2u; voffB[i] = (unsigned)(Rb * K + C) * 2u; }
    const size_t kstep = (size_t)(BK * 2);
    const size_t hstep = (size_t)HALF * K * 2;
    const size_t tstep = 2 * hstep;
    const unsigned ldsw = (unsigned)wid * 1024u;
    const int aoff = lds_byte(wr * 64 + fr, fq * 8), boff = lds_byte(wc * 32 + fr, fq * 8);
#define PG8_SA(b, h) (((b) * 2 + (h)) * HTB)
#define PG8_SB(b, h) ((4 + (b) * 2 + (h)) * HTB)
#define PG8_STAGE(bufoff, gbase, voff) do { _Pragma("unroll") for (int _i = 0; _i < 2; ++_i) \
        __builtin_amdgcn_global_load_lds((const unsigned*)((const char*)(gbase) + (voff)[_i]), (PG8_LAS unsigned*)(lds + (bufoff) + ldsw + _i * 8192), 16, 0, 0); } while (0)
#define PG8_LDA(dst, b, h) do { _Pragma("unroll") for (int m = 0; m < 4; ++m) _Pragma("unroll") for (int k = 0; k < 2; ++k) dst[m][k] = *(const PG8_LAS bf16x8*)(lds + PG8_SA(b, h) + aoff + m * 2048 + k * 1024); } while (0)
#define PG8_LDB(dst, b, h) do { _Pragma("unroll") for (int n = 0; n < 2; ++n) _Pragma("unroll") for (int k = 0; k < 2; ++k) dst[n][k] = *(const PG8_LAS bf16x8*)(lds + PG8_SB(b, h) + boff + n * 2048 + k * 1024); } while (0)
#define PG8_MMA(ai, bj, At, Bt) do { __builtin_amdgcn_s_setprio(1); _Pragma("unroll") for (int m = 0; m < 4; ++m) _Pragma("unroll") for (int n = 0; n < 2; ++n) _Pragma("unroll") for (int k = 0; k < 2; ++k) \
        acc[ai][bj][m][n] = __builtin_amdgcn_mfma_f32_16x16x32_bf16(Bt[n][k], At[m][k], acc[ai][bj][m][n], 0, 0, 0); __builtin_amdgcn_s_setprio(0); } while (0)
#define PG8_WAIT_V(n) asm volatile("s_waitcnt vmcnt(" #n ")" ::: "memory")
#define PG8_WAIT_L(n) asm volatile("s_waitcnt lgkmcnt(" #n ")" ::: "memory")
#define PG8_BAR __builtin_amdgcn_s_barrier()
#define PG8_SCHED __builtin_amdgcn_sched_barrier(0)
    Unit cur, nxt; int ui = 0;
    if (!S.next(0, cur)) return;
    f32x4 acc[2][2][4][2];
#pragma unroll
    for (int a = 0; a < 2; ++a)
#pragma unroll
        for (int b = 0; b < 2; ++b)
#pragma unroll
            for (int m = 0; m < 4; ++m)
#pragma unroll
                for (int n = 0; n < 2; ++n) acc[a][b][m][n] = (f32x4){0.f, 0.f, 0.f, 0.f};
    bf16x8 At[4][2], B0[2][2], B1[2][2];
    const char* cA = (const char*)g.A + (size_t)cur.pm * tstep; const char* cB = (const char*)g.Bt + (size_t)cur.pn * tstep;
    S.a_ready(cur);
    if constexpr (SP2) {
        PG8_STAGE(PG8_SB(0, 0), cB, voffB); PG8_STAGE(PG8_SB(0, 1), cB + hstep, voffB); PG8_STAGE(PG8_SA(0, 0), cA, voffA); PG8_STAGE(PG8_SA(0, 1), cA + hstep, voffA);
        if (wr == 1) PG8_BAR;
        PG8_WAIT_V(2); PG8_BAR;
        PG8_STAGE(PG8_SB(1, 0), cB + kstep, voffB); PG8_STAGE(PG8_SA(1, 0), cA + kstep, voffA); PG8_STAGE(PG8_SB(1, 1), cB + hstep + kstep, voffB);
        PG8_WAIT_V(6); PG8_BAR;
    } else {
        PG8_STAGE(PG8_SB(0, 0), cB, voffB); PG8_STAGE(PG8_SA(0, 0), cA, voffA); PG8_STAGE(PG8_SB(0, 1), cB + hstep, voffB); PG8_STAGE(PG8_SA(0, 1), cA + hstep, voffA);
        if (wr == 1) PG8_BAR;
        PG8_WAIT_V(4); PG8_BAR;
        PG8_STAGE(PG8_SB(1, 0), cB + kstep, voffB); PG8_STAGE(PG8_SA(1, 0), cA + kstep, voffA); PG8_STAGE(PG8_SB(1, 1), cB + hstep + kstep, voffB);
        PG8_WAIT_V(6); PG8_BAR;
    }
    for (;;) {
        const bool has_next = S.next(ui + 1, nxt);
        const char* nA = has_next ? (const char*)g.A + (size_t)nxt.pm * tstep : cA; const char* nB = has_next ? (const char*)g.Bt + (size_t)nxt.pn * tstep : cB;
        for (int t = 0; t < nt; t += 2) {
            const bool last = (t == nt - 2);
            const char* a1 = cA + (size_t)(t + 1) * kstep;
            const char* a2 = last ? nA : cA + (size_t)(t + 2) * kstep; const char* b2 = last ? nB : cB + (size_t)(t + 2) * kstep;
            const char* a3 = a2 + kstep; const char* b3 = b2 + kstep;
            if (last && has_next) S.a_ready(nxt);
            if constexpr (Epi::MIDSCALE) { if (t == nt / 2) E.midscale(acc, cur, wr, fr); }
            if constexpr (SP2) {
            PG8_LDB(B0, 0, 0); PG8_LDB(B1, 0, 1); PG8_SCHED; PG8_LDA(At, 0, 0); PG8_STAGE(PG8_SA(1, 1), a1 + hstep, voffA);
            PG8_WAIT_V(8); PG8_WAIT_L(0); PG8_BAR; PG8_MMA(0, 0, At, B0); PG8_MMA(0, 1, At, B1); PG8_BAR; PG8_SCHED;
            PG8_LDA(At, 0, 1); PG8_STAGE(PG8_SB(0, 0), b2, voffB); PG8_STAGE(PG8_SB(0, 1), b2 + hstep, voffB); PG8_STAGE(PG8_SA(0, 0), a2, voffA);
            PG8_WAIT_V(8); PG8_WAIT_L(0); PG8_BAR; PG8_MMA(1, 0, At, B0); PG8_MMA(1, 1, At, B1); PG8_BAR; PG8_SCHED;
            PG8_LDB(B0, 1, 0); PG8_LDB(B1, 1, 1); PG8_SCHED; PG8_LDA(At, 1, 0); PG8_STAGE(PG8_SA(0, 1), a2 + hstep, voffA);
            PG8_WAIT_V(8); PG8_WAIT_L(0); PG8_BAR; PG8_MMA(0, 0, At, B0); PG8_MMA(0, 1, At, B1); PG8_BAR; PG8_SCHED;
            PG8_LDA(At, 1, 1); PG8_STAGE(PG8_SB(1, 0), b3, voffB); PG8_STAGE(PG8_SB(1, 1), b3 + hstep, voffB); PG8_STAGE(PG8_SA(1, 0), a3, voffA);
            PG8_WAIT_V(8); PG8_WAIT_L(0); PG8_BAR; PG8_MMA(1, 0, At, B0); PG8_MMA(1, 1, At, B1); PG8_BAR; PG8_SCHED;
            } else {
            PG8_LDB(B0, 0, 0); PG8_SCHED; PG8_LDA(At, 0, 0); PG8_STAGE(PG8_SA(1, 1), a1 + hstep, voffA);
            PG8_WAIT_L(8); PG8_BAR; PG8_WAIT_L(0); PG8_MMA(0, 0, At, B0); PG8_BAR; PG8_SCHED;
            PG8_LDB(B1, 0, 1); PG8_STAGE(PG8_SB(0, 0), b2, voffB);
            PG8_BAR; PG8_WAIT_L(0); PG8_MMA(0, 1, At, B1); PG8_BAR;
            PG8_LDA(At, 0, 1); PG8_STAGE(PG8_SA(0, 0), a2, voffA);
            PG8_BAR; PG8_WAIT_L(0); PG8_MMA(1, 0, At, B0); PG8_BAR; PG8_SCHED;
            PG8_STAGE(PG8_SB(0, 1), b2 + hstep, voffB);
            PG8_WAIT_V(6); PG8_BAR; PG8_MMA(1, 1, At, B1); PG8_BAR;
            PG8_LDB(B0, 1, 0); PG8_SCHED; PG8_LDA(At, 1, 0); PG8_STAGE(PG8_SA(0, 1), a2 + hstep, voffA);
            PG8_WAIT_L(8); PG8_BAR; PG8_WAIT_L(0); PG8_MMA(0, 0, At, B0); PG8_BAR; PG8_SCHED;
            PG8_LDB(B1, 1, 1); PG8_STAGE(PG8_SB(1, 0), b3, voffB);
            PG8_BAR; PG8_WAIT_L(0); PG8_MMA(0, 1, At, B1); PG8_BAR;
            PG8_LDA(At, 1, 1); PG8_STAGE(PG8_SA(1, 0), a3, voffA);
            PG8_BAR; PG8_WAIT_L(0); PG8_MMA(1, 0, At, B0); PG8_BAR; PG8_SCHED;
            PG8_STAGE(PG8_SB(1, 1), b3 + hstep, voffB);
            PG8_WAIT_V(6); PG8_BAR; PG8_MMA(1, 1, At, B1); PG8_BAR;
            }
        }
        if constexpr (ALIGN_EPI) { if (wr == 0) PG8_BAR; }
        if constexpr (!Epi::AFTER_DRAIN) { E(acc, cur, wr, wc, fr, fq); S.done(cur); }
        if (!has_next) break;
#pragma unroll
        for (int a = 0; a < 2; ++a)
#pragma unroll
            for (int b = 0; b < 2; ++b)
#pragma unroll
                for (int m = 0; m < 4; ++m)
#pragma unroll
                    for (int n = 0; n < 2; ++n) acc[a][b][m][n] = (f32x4){0.f, 0.f, 0.f, 0.f};
        cur = nxt; cA = nA; cB = nB; ++ui;
        if constexpr (ALIGN_EPI) { if (wr == 1) PG8_BAR; }
    }
    PG8_WAIT_V(0);
    if constexpr (!ALIGN_EPI) { if (wr == 0) PG8_BAR; }
    PG8_BAR;
    if constexpr (Epi::AFTER_DRAIN) { E.fused(acc, cur, wr, wc, fr, fq, lds, wid, lane); S.done(cur); }
#undef PG8_SA
#undef PG8_SB
#undef PG8_STAGE
#undef PG8_LDA
#undef PG8_LDB
#undef PG8_MMA
#undef PG8_WAIT_V
#undef PG8_WAIT_L
#undef PG8_BAR
#undef PG8_SCHED
}
}
namespace pg8 {
struct EpiSplit {
  static constexpr bool PERM = true, AFTER_DRAIN = false, MIDSCALE = false;
  unsigned char* ws; int layer;
  __device__ __forceinline__ void operator()(const f32x4 (&acc)[2][2][4][2], const Unit& u, int wr, int wc, int fr_, int fq_) const {
    int fr = fr_, fq = fq_; asm volatile("" : "+v"(fr), "+v"(fq));
    unsigned char* ws = this->ws; asm volatile("" : "+s"(ws));
    float rs[2][4]; f32x4 sw[2][2];
#pragma unroll
    for (int ai = 0; ai < 2; ++ai)
#pragma unroll
      for (int m = 0; m < 4; ++m) rs[ai][m] = 1.f;
#pragma unroll
    for (int bj = 0; bj < 2; ++bj)
#pragma unroll
      for (int n = 0; n < 2; ++n) sw[bj][n] = (f32x4){0.f, 0.f, 0.f, 0.f};
    if (layer == 1) { const float* sq = (const float*)(ws + O_SSQ1); const float* sWp = (const float*)(ws + O_SWO);
#pragma unroll
      for (int ai = 0; ai < 2; ++ai)
#pragma unroll
        for (int m = 0; m < 4; ++m) rs[ai][m] = rsqrtf(sq[u.pm * BM + ai * HALF + wr * 64 + m * 16 + fr] * (1.f / DM) + EPS);
#pragma unroll
      for (int bj = 0; bj < 2; ++bj)
#pragma unroll
        for (int n = 0; n < 2; ++n) sw[bj][n] = *(const f32x4*)(sWp + u.pn * BM + bj * HALF + wc * 32 + 8 * fq + 4 * n); }
    bf16_t* dst; int ld, c0, act = 0; const int pn = u.pn;
    if (layer == 0) {
      if (pn < 4)       { dst = (bf16_t*)(ws + O_RA);             ld = 1024; c0 = pn * 256; }
      else if (pn == 4) { dst = (bf16_t*)(ws + O_KR);             ld = 256;  c0 = 0; }
      else if (pn == 5) { dst = (bf16_t*)(ws + O_V0);             ld = 256;  c0 = 0; }
      else if (pn < 10) { dst = (bf16_t*)(ws + O_RA + SZ_LK);     ld = 1024; c0 = (pn - 6) * 256; act = 1; }
      else if (pn < 14) { dst = (bf16_t*)(ws + O_RA + 2 * SZ_LK); ld = 1024; c0 = (pn - 10) * 256; }
      else              { dst = (bf16_t*)(ws + O_RA + 3 * SZ_LK); ld = 1024; c0 = (pn - 14) * 256; act = 1; }
    } else {
      if (pn < 12)      { dst = (bf16_t*)(ws + O_RA + (size_t)(pn >> 2) * SZ_LK); ld = 1024; c0 = (pn & 3) * 256; }
      else if (pn < 16) { dst = (bf16_t*)(ws + O_RA + 3 * SZ_LK); ld = 1024; c0 = (pn - 12) * 256; act = 1; }
      else if (pn < 20) { dst = (bf16_t*)(ws + O_ZS);             ld = 1024; c0 = (pn - 16) * 256; act = 1; }
      else if (pn < 26) { dst = (bf16_t*)(ws + O_XBCR);           ld = 1536; c0 = (pn - 20) * 256; }
      else {
        if (wc == 0) {
          float* d = (float*)(ws + O_DTR);
#pragma unroll
          for (int ai = 0; ai < 2; ++ai)
#pragma unroll
            for (int m = 0; m < 4; ++m) { const int row = u.pm * BM + ai * HALF + wr * 64 + m * 16 + fr;
              *(f32x4*)(d + (size_t)row * 32 + 8 * fq)     = acc[ai][0][m][0] * rs[ai][m] + sw[0][0];
              *(f32x4*)(d + (size_t)row * 32 + 8 * fq + 4) = acc[ai][0][m][1] * rs[ai][m] + sw[0][1]; }
        }
        return;
      }
    }
    const int row0 = u.pm * BM + wr * 64 + fr, col0 = c0 + wc * 32 + 8 * fq;
#pragma unroll
    for (int ai = 0; ai < 2; ++ai)
#pragma unroll
      for (int m = 0; m < 4; ++m) { bf16_t* rowp = dst + (size_t)(row0 + ai * HALF + m * 16) * ld + col0;
#pragma unroll
        for (int bj = 0; bj < 2; ++bj) { f32x4 v0 = acc[ai][bj][m][0] * rs[ai][m] + sw[bj][0], v1 = acc[ai][bj][m][1] * rs[ai][m] + sw[bj][1];
          if (act) {
#pragma unroll
            for (int e = 0; e < 4; ++e) { v0[e] = silu_f(v0[e]); v1[e] = silu_f(v1[e]); } }
          u32x4 o; o[0] = pk2(v0[0], v0[1]); o[1] = pk2(v0[2], v0[3]); o[2] = pk2(v1[0], v1[1]); o[3] = pk2(v1[2], v1[3]);
          *(u32x4*)(rowp + bj * HALF) = o; } }
  }
};
struct EpiGlu {
  static constexpr bool PERM = true, AFTER_DRAIN = false, MIDSCALE = false;
  unsigned char* ws; const float* bias;
  __device__ __forceinline__ void operator()(const f32x4 (&acc)[2][2][4][2], const Unit& u, int wr, int wc, int fr_, int fq_) const {
    int fr = fr_, fq = fq_; asm volatile("" : "+v"(fr), "+v"(fq));
    unsigned char* ws = this->ws; const float* bias = this->bias; asm volatile("" : "+s"(ws), "+s"(bias));
    const bf16_t* gb = (const bf16_t*)(ws + O_RA + 3 * SZ_LK); bf16_t* oa = (bf16_t*)(ws + O_OA);
    const int row0 = u.pm * BM + wr * 64 + fr, col = u.pn * 128 + wc * 32 + 8 * fq;
    const f32x4 bv0 = *(const f32x4*)(bias + col), bv1 = *(const f32x4*)(bias + col + 4), bg0 = *(const f32x4*)(bias + 1024 + col), bg1 = *(const f32x4*)(bias + 1024 + col + 4);
#pragma unroll
    for (int ai = 0; ai < 2; ++ai)
#pragma unroll
      for (int m = 0; m < 4; ++m) { const size_t row = (size_t)(row0 + ai * HALF + m * 16);
        const u32x4 g = *(const u32x4*)(gb + row * 1024 + col);
        f32x4 a0 = acc[ai][0][m][0] + bv0, a1 = acc[ai][0][m][1] + bv1, t0 = acc[ai][1][m][0] + bg0, t1 = acc[ai][1][m][1] + bg1;
        float r[8];
#pragma unroll
        for (int e = 0; e < 4; ++e) { r[e] = a0[e] * sigmoid_f(t0[e]); r[4 + e] = a1[e] * sigmoid_f(t1[e]); }
        u32x4 o;
#pragma unroll
        for (int e = 0; e < 4; ++e) o[e] = pk2(r[2 * e] * lo2f(g[e]), r[2 * e + 1] * hi2f(g[e]));
        *(u32x4*)(oa + row * 2048 + 1024 + col) = o; }
  }
};
struct EpiRes {
  static constexpr bool PERM = false, AFTER_DRAIN = false, MIDSCALE = false;
  const float* xres; float* out; const float* gate;
  __device__ __forceinline__ void operator()(const f32x4 (&acc)[2][2][4][2], const Unit& u, int wr, int wc, int fr_, int fq_) const {
    int fr = fr_, fq = fq_; asm volatile("" : "+v"(fr), "+v"(fq));
    const float* xres = this->xres; float* out = this->out; const float* gate = this->gate; asm volatile("" : "+s"(xres), "+s"(out), "+s"(gate));
    const int row0 = u.pm * BM + wr * 64 + fr, col0 = u.pn * BM + wc * 32 + 4 * fq;
    f32x4 gv[2][2];
#pragma unroll
    for (int bj = 0; bj < 2; ++bj)
#pragma unroll
      for (int n = 0; n < 2; ++n) gv[bj][n] = *(const f32x4*)(gate + col0 + bj * HALF + n * 16);
#pragma unroll
    for (int ai = 0; ai < 2; ++ai)
#pragma unroll
      for (int m = 0; m < 4; ++m) { const size_t off = (size_t)(row0 + ai * HALF + m * 16) * DM + col0;
#pragma unroll
        for (int bj = 0; bj < 2; ++bj)
#pragma unroll
          for (int n = 0; n < 2; ++n) { const f32x4 xr = *(const f32x4*)(xres + off + bj * HALF + n * 16);
            *(f32x4*)(out + off + bj * HALF + n * 16) = xr + gv[bj][n] * acc[ai][bj][m][n]; } }
  }
};
struct EpiResX {
  static constexpr bool PERM = false, AFTER_DRAIN = false, MIDSCALE = false;
  const float* xres; float* out; const float* gate; bf16_t* xb; float* ssq1;
  __device__ __forceinline__ void operator()(const f32x4 (&acc)[2][2][4][2], const Unit& u, int wr, int wc, int fr_, int fq_) const {
    int fr = fr_, fq = fq_; asm volatile("" : "+v"(fr), "+v"(fq));
    const float* xres = this->xres; float* out = this->out; const float* gate = this->gate; asm volatile("" : "+s"(xres), "+s"(out), "+s"(gate));
    bf16_t* xbp = this->xb; float* sqp = this->ssq1; asm volatile("" : "+s"(xbp), "+s"(sqp));
    const int row0 = u.pm * BM + wr * 64 + fr, col0 = u.pn * BM + wc * 32 + 4 * fq;
    f32x4 gv[2][2];
#pragma unroll
    for (int bj = 0; bj < 2; ++bj)
#pragma unroll
      for (int n = 0; n < 2; ++n) gv[bj][n] = *(const f32x4*)(gate + col0 + bj * HALF + n * 16);
#pragma unroll
    for (int ai = 0; ai < 2; ++ai)
#pragma unroll
      for (int m = 0; m < 4; ++m) { const size_t off = (size_t)(row0 + ai * HALF + m * 16) * DM + col0; float s = 0.f;
#pragma unroll
        for (int bj = 0; bj < 2; ++bj)
#pragma unroll
          for (int n = 0; n < 2; ++n) { const f32x4 xr = *(const f32x4*)(xres + off + bj * HALF + n * 16);
            const f32x4 v = xr + gv[bj][n] * acc[ai][bj][m][n];
            u32x2 w = {pk2(v[0], v[1]), pk2(v[2], v[3])}; *(u32x2*)(xbp + off + bj * HALF + n * 16) = w;
            s += v[0] * v[0] + v[1] * v[1] + v[2] * v[2] + v[3] * v[3]; }
        s += __shfl_xor(s, 16); s += __shfl_xor(s, 32);
        if (fq == 0) atomicAdd(sqp + row0 + ai * HALF + m * 16, s); }
  }
};
struct EpiResScale {
  static constexpr bool PERM = false, AFTER_DRAIN = false, MIDSCALE = true;
  const float* xres; float* out; const float* gate; const float* ssq;
  __device__ __forceinline__ void midscale(f32x4 (&acc)[2][2][4][2], const Unit& u, int wr, int fr_) const {
    int fr = fr_; asm volatile("" : "+v"(fr)); const float* sq = this->ssq; asm volatile("" : "+s"(sq));
#pragma unroll
    for (int ai = 0; ai < 2; ++ai)
#pragma unroll
      for (int m = 0; m < 4; ++m) { const int row = u.pm * BM + ai * HALF + wr * 64 + m * 16 + fr;
        const float s0 = sq[(size_t)row * 2], s1 = sq[(size_t)row * 2 + 1]; const float rstd = rsqrtf((s0 + s1) * (1.f / 1024.f) + EPS);
#pragma unroll
        for (int bj = 0; bj < 2; ++bj)
#pragma unroll
          for (int n = 0; n < 2; ++n) acc[ai][bj][m][n] *= rstd; }
  }
  __device__ __forceinline__ void operator()(const f32x4 (&acc)[2][2][4][2], const Unit& u, int wr, int wc, int fr_, int fq_) const {
    int fr = fr_, fq = fq_; asm volatile("" : "+v"(fr), "+v"(fq));
    const float* xres = this->xres; float* out = this->out; const float* gate = this->gate; asm volatile("" : "+s"(xres), "+s"(out), "+s"(gate));
    const bf16_t* xresb = (const bf16_t*)xres;
    const int row0 = u.pm * BM + wr * 64 + fr, col0 = u.pn * BM + wc * 32 + 4 * fq;
    f32x4 gv[2][2];
#pragma unroll
    for (int bj = 0; bj < 2; ++bj)
#pragma unroll
      for (int n = 0; n < 2; ++n) gv[bj][n] = *(const f32x4*)(gate + col0 + bj * HALF + n * 16);
#pragma unroll
    for (int ai = 0; ai < 2; ++ai)
#pragma unroll
      for (int m = 0; m < 4; ++m) { const size_t off = (size_t)(row0 + ai * HALF + m * 16) * DM + col0;
#pragma unroll
        for (int bj = 0; bj < 2; ++bj)
#pragma unroll
          for (int n = 0; n < 2; ++n) { const u32x2 xw = *(const u32x2*)(xresb + off + bj * HALF + n * 16); const f32x4 xr = {lo2f(xw[0]), hi2f(xw[0]), lo2f(xw[1]), hi2f(xw[1])};
            *(f32x4*)(out + off + bj * HALF + n * 16) = xr + gv[bj][n] * acc[ai][bj][m][n]; } }
  }
};
}
using bf16 = bf16_t;
#define KSWZ(row, colB) ((row) * 256 + ((colB) ^ (((row) & 7) << 4)))
#define SBAR() __builtin_amdgcn_sched_barrier(0)
__device__ __forceinline__ int crow(int r, int hi) { return (r & 3) + 8 * (r >> 2) + 4 * hi; }
__device__ __forceinline__ unsigned cvtpk(float lo, float hi) {
  unsigned r; asm volatile("v_cvt_pk_bf16_f32 %0, %1, %2" : "=v"(r) : "v"(lo), "v"(hi)); return r;
}
__device__ __forceinline__ void partialSM(f32x16& p0, f32x16& p1, float& m_reg, float& mn, float& alpha) {
  constexpr float C = SCALE * 1.4426950408889634f;
  float pmax = p0[0]; for (int r = 1; r < 16; ++r) pmax = fmaxf(pmax, p0[r]); for (int r = 0; r < 16; ++r) pmax = fmaxf(pmax, p1[r]);
  { auto rr = __builtin_amdgcn_permlane32_swap(__float_as_uint(pmax), __float_as_uint(pmax), false, false);
    pmax = fmaxf(__uint_as_float(rr[0]), __uint_as_float(rr[1])); }
  if (__builtin_expect(__all(pmax - m_reg <= THR / SCALE), 1)) { mn = m_reg; alpha = 1.f; }
  else { mn = fmaxf(m_reg, pmax); alpha = __builtin_amdgcn_exp2f((m_reg - mn) * C); m_reg = mn; }
  float mnC = -mn * C;
  for (int r = 0; r < 16; ++r) p0[r] = fmaf(p0[r], C, mnC); for (int r = 0; r < 16; ++r) p1[r] = fmaf(p1[r], C, mnC);
  for (int r = 0; r < 16; ++r) p0[r] = __builtin_amdgcn_exp2f(p0[r]);
}
__device__ __forceinline__ void finishSM(f32x16& p0, f32x16& p1, float alpha, float& l_reg, bf16x8& pa0, bf16x8& pa1, bf16x8& pa2, bf16x8& pa3) {
  for (int r = 0; r < 16; ++r) p1[r] = __builtin_amdgcn_exp2f(p1[r]);
  float ps = 0; for (int r = 0; r < 16; ++r) ps += p0[r]; for (int r = 0; r < 16; ++r) ps += p1[r];
  { auto rr = __builtin_amdgcn_permlane32_swap(__float_as_uint(ps), __float_as_uint(ps), false, false);
    ps = __uint_as_float(rr[0]) + __uint_as_float(rr[1]); }
  l_reg = l_reg * alpha + ps;
#define PK4(P, BASE, OUT) do { unsigned a0 = cvtpk(P[BASE + 0], P[BASE + 1]), a1 = cvtpk(P[BASE + 2], P[BASE + 3]);   \
    unsigned b0 = cvtpk(P[BASE + 4], P[BASE + 5]), b1 = cvtpk(P[BASE + 6], P[BASE + 7]);                              \
    auto r0 = __builtin_amdgcn_permlane32_swap(a0, b0, false, false); auto r1 = __builtin_amdgcn_permlane32_swap(a1, b1, false, false); \
    u32x4 w = {r0[0], r1[0], r0[1], r1[1]}; OUT = *reinterpret_cast<bf16x8*>(&w); } while (0)
  PK4(p0, 0, pa0); PK4(p0, 8, pa1); PK4(p1, 0, pa2); PK4(p1, 8, pa3);
#undef PK4
}
template <bool ZERO, bool QLDS> __device__ __forceinline__ void qkt(f32x16& p0, f32x16& p1, const bf16* Ks, const bf16x8* qr, int r32, int hi, const char* qrow) {
  if (ZERO) { p0 = f32x16{}; p1 = f32x16{}; }
  for (int d0 = 0; d0 < 8; ++d0) { int cb = (d0 * 16 + hi * 8) * 2;
    bf16x8 b0 = *reinterpret_cast<const bf16x8*>((const char*)Ks + KSWZ(r32, cb));
    bf16x8 b1 = *reinterpret_cast<const bf16x8*>((const char*)Ks + KSWZ(32 + r32, cb));
    bf16x8 q; if (QLDS) q = *reinterpret_cast<const bf16x8*>(qrow + (cb ^ ((r32 & 7) << 4))); else q = qr[d0];
    p0 = __builtin_amdgcn_mfma_f32_32x32x16_bf16(b0, q, p0, 0, 0, 0);
    p1 = __builtin_amdgcn_mfma_f32_32x32x16_bf16(b1, q, p1, 0, 0, 0); }
}
__device__ __forceinline__ int v_st(int k, int c) { const int kk = (k & ~0xC) | ((k & 4) << 1) | ((k & 8) >> 1); return ((kk >> 3) * 4 + (c >> 5)) * 512 + ((kk & 7) * 32 + (c & 31)) * 2; }
__device__ __forceinline__ int v_rd_base(int lane) { return ((lane & 3) << 3) | (((lane >> 2) & 3) << 6) | (((lane >> 4) & 1) << 5) | (((lane >> 5) & 1) << 8); }
constexpr int v_rd_off(int d0, int ks, int half) { return d0 * 512 + ks * 4096 + half * 2048; }
template <int OFF> __device__ __forceinline__ s16x4 tr_read(int vb) {
  s16x4 r; asm volatile("ds_read_b64_tr_b16 %0, %1 offset:%2" : "=&v"(r) : "v"(vb), "i"(OFF) : "memory"); return r;
}
template <int D0> __device__ __forceinline__ void pv_one(f32x16& od, int vb, bf16x8 pa0, bf16x8 pa1, bf16x8 pa2, bf16x8 pa3) {
  const s16x4 l0 = tr_read<v_rd_off(D0, 0, 0)>(vb), h0 = tr_read<v_rd_off(D0, 0, 1)>(vb), l1 = tr_read<v_rd_off(D0, 1, 0)>(vb), h1 = tr_read<v_rd_off(D0, 1, 1)>(vb);
  const s16x4 l2 = tr_read<v_rd_off(D0, 2, 0)>(vb), h2 = tr_read<v_rd_off(D0, 2, 1)>(vb), l3 = tr_read<v_rd_off(D0, 3, 0)>(vb), h3 = tr_read<v_rd_off(D0, 3, 1)>(vb);
  asm volatile("s_waitcnt lgkmcnt(0)" ::: "memory"); SBAR();
#define PK(L, H) (bf16x8){L[0], L[1], L[2], L[3], H[0], H[1], H[2], H[3]}
  od = __builtin_amdgcn_mfma_f32_32x32x16_bf16(pa0, PK(l0, h0), od, 0, 0, 0);
  od = __builtin_amdgcn_mfma_f32_32x32x16_bf16(pa1, PK(l1, h1), od, 0, 0, 0);
  od = __builtin_amdgcn_mfma_f32_32x32x16_bf16(pa2, PK(l2, h2), od, 0, 0, 0);
  od = __builtin_amdgcn_mfma_f32_32x32x16_bf16(pa3, PK(l3, h3), od, 0, 0, 0);
#undef PK
}
__device__ __forceinline__ void pv_d0(f32x16* o, int vb, bf16x8 pa0, bf16x8 pa1, bf16x8 pa2, bf16x8 pa3) {
  pv_one<0>(o[0], vb, pa0, pa1, pa2, pa3); pv_one<1>(o[1], vb, pa0, pa1, pa2, pa3); pv_one<2>(o[2], vb, pa0, pa1, pa2, pa3); pv_one<3>(o[3], vb, pa0, pa1, pa2, pa3);
}
constexpr size_t SHM_V = 64 * 128 * 2, SHM_K = 64 * 128 * 2, SHM_ATTN = 2 * SHM_V + 2 * SHM_K + 8 * 64 * 4;
template <int MODE, int LDQ, int LDK, int LDO, int SDEPTH>
__device__ __forceinline__ void attn_body(const bf16_t* __restrict__ Qb, const bf16_t* __restrict__ Kh, const bf16_t* __restrict__ Vh, const bf16_t* __restrict__ Gb,
                                          bf16_t* __restrict__ Ob, const float* __restrict__ qnw, const int NT, const int tok0, const int r0, const int t0, char* lds, const int tid) {
  const int wid = __builtin_amdgcn_readfirstlane(tid >> 6), lane = tid & 63, r32 = lane & 31, hi = lane >> 5;
  bf16_t* V_lds = (bf16_t*)lds; bf16_t* K_lds = (bf16_t*)(lds + 2 * SHM_V);
  float* ws = (float*)(lds + 2 * SHM_V + 2 * SHM_K) + wid * 64; float* li_l = ws; float* al_l = ws + 32;
  const __attribute__((address_space(3))) float* biasT = (const __attribute__((address_space(3))) float*)(lds + SHM_ATTN) + 64;
  float m_reg = MODE ? -1e29f : -1e30f, l_reg = 0; f32x16 o[4] = {}; bf16x8 qr[8];
  char* qt = MODE ? lds + 73728 : lds;
  {
    const int prow_ = tid >> 1, half = tid & 1;
    const bf16_t* Qw = Qb + (long)prow_ * LDQ + half * 64;
    u32x4 raw[8]; float ss = 0.f;
#pragma unroll
    for (int j = 0; j < 8; ++j) { raw[j] = *reinterpret_cast<const u32x4*>(Qw + j * 8);
#pragma unroll
      for (int e = 0; e < 4; ++e) { const float a = lo2f(raw[j][e]), b = hi2f(raw[j][e]); ss += a * a + b * b; } }
    ss += __shfl_xor(ss, 1);
    const float rstd = rsqrtf(ss * (1.f / 128.f) + EPS);
    const int tok = tok0 + prow_; const float pos = half ? (float)(tok & 63) : (float)(tok >> 6);
#pragma unroll
    for (int j = 0; j < 8; ++j) {
      const f32x4 w0 = *reinterpret_cast<const f32x4*>(qnw + half * 64 + j * 8), w1 = *reinterpret_cast<const f32x4*>(qnw + half * 64 + j * 8 + 4);
      float v[8];
#pragma unroll
      for (int e = 0; e < 4; ++e) { v[2 * e] = lo2f(raw[j][e]) * rstd; v[2 * e + 1] = hi2f(raw[j][e]) * rstd; }
      v[0] *= w0[0]; v[1] *= w0[1]; v[2] *= w0[2]; v[3] *= w0[3]; v[4] *= w1[0]; v[5] *= w1[1]; v[6] *= w1[2]; v[7] *= w1[3];
      if (MODE == 0) {
#pragma unroll
        for (int e2 = 0; e2 < 4; ++e2) { const int i = j * 4 + e2;
          const float inv = exp2f(-(float)i * (13.287712379549449f / 32.f)); float sn, cs; sincos_rev(pos * inv, sn, cs);
          const float x1 = v[2 * e2], x2 = v[2 * e2 + 1]; v[2 * e2] = x1 * cs - x2 * sn; v[2 * e2 + 1] = x1 * sn + x2 * cs; } }
      u32x4 w = {pk2(v[0], v[1]), pk2(v[2], v[3]), pk2(v[4], v[5]), pk2(v[6], v[7])};
      *reinterpret_cast<u32x4*>(qt + KSWZ(prow_, (half * 64 + j * 8) * 2)) = w; }
    __syncthreads();
    if (MODE == 0) {
#pragma unroll
      for (int d0 = 0; d0 < 8; ++d0) qr[d0] = *reinterpret_cast<const bf16x8*>(lds + KSWZ(wid * 32 + r32, (d0 * 16 + hi * 8) * 2));
      __syncthreads(); }
  }
  const char* qrow = qt + (wid * 32 + r32) * 256;
  const int rq = r0 + (wid >> 1), qc = (wid & 1) * 32 + r32, rs = min(max(rq - 4, 0), 248), cs0 = min(max(qc - 8, 0), 48);
  const int mbase = 232 - rq * 31 - qc;
#define NA_INIT(P0, P1, J) do { if (MODE == 1) { const int kt = t0 + (J); \
    if ((kt >= rs) && (kt < rs + 8)) { int ib = mbase + kt * 31, csx = cs0; asm volatile("" : "+v"(ib), "+v"(csx)); \
      _Pragma("unroll") for (int r = 0; r < 16; ++r) { const int kc0 = crow(r, hi), kc1 = 32 + kc0; \
        const bool ok0 = (unsigned)(kc0 - csx) < 16u, ok1 = (unsigned)(kc1 - csx) < 16u; \
        const float b0 = biasT[ib + kc0], b1 = biasT[ib + kc1]; \
        P0[r] = ok0 ? b0 : -1e30f; P1[r] = ok1 ? b1 : -1e30f; } } \
    } } while (0)
#define TILE_OK(J) (MODE == 0 || ((t0 + (J)) >= rs && (t0 + (J)) < rs + 8))
#define QKT(P0, P1, KP, J, V) do { V = TILE_OK(J); if (V) { NA_INIT(P0, P1, J); qkt<MODE == 0, MODE == 1>(P0, P1, KP, qr, r32, hi, qrow); } } while (0)
#define PSM(P0, P1, MN, AL, V) do { if (V) partialSM(P0, P1, m_reg, MN, AL); else { MN = m_reg; AL = 1.f; } } while (0)
#define FSM_PV(P0, P1, AL, VB, V) do { if (V) { finishSM(P0, P1, AL, l_reg, pa0, pa1, pa2, pa3); SBAR(); } } while (0)
  const int sr = tid >> 4, sc = (tid & 15) * 8, vst0 = v_st(sr, sc), vst1 = v_st(32 + sr, sc);
  const int vb0 = (int)(uintptr_t)V_lds + v_rd_base(lane);
  struct { bf16x8 vs0, vs1, ks0, ks1; } sr_[SDEPTH];
#define LD8(p) (*reinterpret_cast<const bf16x8*>(p))
#define SLOAD(i, k0) do { sr_[i].vs0 = LD8(&Vh[(long)((k0) + sr) * LDK + sc]); sr_[i].vs1 = LD8(&Vh[(long)((k0) + 32 + sr) * LDK + sc]); \
    sr_[i].ks0 = LD8(&Kh[(long)((k0) + sr) * LDK + sc]); sr_[i].ks1 = LD8(&Kh[(long)((k0) + 32 + sr) * LDK + sc]); } while (0)
#define SWRITE(b, i) do { *(bf16x8*)((char*)V_lds + (b) * SHM_V + vst0) = sr_[i].vs0;          \
    *(bf16x8*)((char*)V_lds + (b) * SHM_V + vst1) = sr_[i].vs1; int kc = sc * 2;               \
    *(bf16x8*)((char*)K_lds + (b) * SHM_K + KSWZ(sr, kc)) = sr_[i].ks0;                       \
    *(bf16x8*)((char*)K_lds + (b) * SHM_K + KSWZ(32 + sr, kc)) = sr_[i].ks1; } while (0)
#define SWAIT() do { if constexpr (SDEPTH == 2) asm volatile("s_waitcnt vmcnt(4)" ::: "memory"); else asm volatile("s_waitcnt vmcnt(0)" ::: "memory"); } while (0)
#define RESC(a) do { if (__any((a) < 1.f)) { if (hi == 0) al_l[r32] = (a); asm volatile("s_waitcnt lgkmcnt(0)" ::: "memory"); \
    for (int d = 0; d < 4; ++d) for (int r = 0; r < 16; ++r) o[d][r] *= al_l[crow(r, hi)]; } } while (0)
  f32x16 pA0, pA1, pB0, pB1; float mnA, mnB, alA, alB; bf16x8 pa0, pa1, pa2, pa3;
  constexpr int SE = 0, SO = SDEPTH - 1, KVBLK = 64;
  bool vA = true, vB = true;
  SLOAD(SE, 0); asm volatile("s_waitcnt vmcnt(0)" ::: "memory"); SWRITE(0, SE); __syncthreads();
  QKT(pA0, pA1, K_lds, 0, vA); PSM(pA0, pA1, mnA, alA, vA);
  SLOAD(SO, KVBLK); if constexpr (SDEPTH == 2) { if (2 < NT) SLOAD(SE, 2 * KVBLK); }
  SWAIT(); SWRITE(1, SO); __syncthreads();
  for (int j = 1; j + 1 < NT; j += 2) {
    SBAR(); QKT(pB0, pB1, (bf16_t*)((char*)K_lds + SHM_K), j, vB);
    if (vA) finishSM(pA0, pA1, alA, l_reg, pa0, pa1, pa2, pa3); SBAR();
    SLOAD(SO, (j + SDEPTH) * KVBLK); SBAR();
    if (vA) pv_d0(o, vb0, pa0, pa1, pa2, pa3); PSM(pB0, pB1, mnB, alB, vB);
    __syncthreads(); SWAIT(); SWRITE(0, SE);
    RESC(alB); __syncthreads();
    SBAR(); QKT(pA0, pA1, K_lds, j + 1, vA);
    if (vB) finishSM(pB0, pB1, alB, l_reg, pa0, pa1, pa2, pa3); SBAR();
    if (SDEPTH == 1 || j + 3 < NT) SLOAD(SE, (j + 1 + SDEPTH) * KVBLK); SBAR();
    if (vB) pv_d0(o, vb0 + (int)SHM_V, pa0, pa1, pa2, pa3); PSM(pA0, pA1, mnA, alA, vA);
    __syncthreads(); SWAIT(); SWRITE(1, SO);
    RESC(alA); __syncthreads();
  }
  SBAR(); QKT(pB0, pB1, (bf16_t*)((char*)K_lds + SHM_K), NT - 1, vB);
  if (vA) finishSM(pA0, pA1, alA, l_reg, pa0, pa1, pa2, pa3); SBAR();
  if (vA) pv_d0(o, vb0, pa0, pa1, pa2, pa3); PSM(pB0, pB1, mnB, alB, vB);
  __syncthreads(); RESC(alB);
  if (vB) { finishSM(pB0, pB1, alB, l_reg, pa0, pa1, pa2, pa3); SBAR();
    pv_d0(o, vb0 + (int)SHM_V, pa0, pa1, pa2, pa3); }
  if (hi == 0) li_l[r32] = l_reg; asm volatile("s_waitcnt lgkmcnt(0)" ::: "memory");
  float rli[16];
#pragma unroll
  for (int r = 0; r < 16; ++r) rli[r] = __builtin_amdgcn_rcpf(li_l[crow(r, hi)]);
  __syncthreads();
  { bf16_t* Ot = (bf16_t*)lds + wid * 32 * 128;
#pragma unroll
    for (int r = 0; r < 16; ++r)
#pragma unroll
      for (int d0 = 0; d0 < 4; ++d0) Ot[crow(r, hi) * 128 + d0 * 32 + r32] = f2bf(o[d0][r] * rli[r]);
    WAVE_LDS_FENCE();
#pragma unroll 2
    for (int i = 0; i < 8; ++i) { const int id = lane + 64 * i, row = id >> 4, cc = id & 15;
      const u32x4 ov = *reinterpret_cast<const u32x4*>(Ot + row * 128 + cc * 8);
      const u32x4 gv = *reinterpret_cast<const u32x4*>(Gb + (long)(wid * 32 + row) * 1024 + cc * 8);
      u32x4 w;
#pragma unroll
      for (int e = 0; e < 4; ++e) w[e] = pk2(lo2f(ov[e]) * lo2f(gv[e]), hi2f(ov[e]) * hi2f(gv[e]));
      *reinterpret_cast<u32x4*>(Ob + (long)(wid * 32 + row) * LDO + cc * 8) = w; }
  }
#undef NA_INIT
#undef QKT
#undef PSM
#undef FSM_PV
#undef TILE_OK
#undef LD8
#undef SLOAD
#undef SWRITE
#undef SWAIT
#undef RESC
}
__device__ __forceinline__ void p0_transpose_item(const float* __restrict__ W, int N, int K, bf16_t* __restrict__ WT, int k0, int nrow0, int srccol0, float* scr, int lane,
                                                  int kd0 = -1, const float* __restrict__ kscale = nullptr) {
  if (kd0 < 0) kd0 = k0;
  if (srccol0 >= 0) {
    f32x4 v[8];
#pragma unroll
    for (int i = 0; i < 8; ++i) v[i] = *(const f32x4*)(W + (size_t)(k0 + 8 * i + (lane >> 3)) * N + srccol0 + (lane & 7) * 4);
    if (kscale) {
#pragma unroll
      for (int i = 0; i < 8; ++i) v[i] *= kscale[k0 + 8 * i + (lane >> 3)]; }
#pragma unroll
    for (int i = 0; i < 8; ++i) { float* s = scr + (8 * i + (lane >> 3)) * 33 + (lane & 7) * 4; s[0] = v[i][0]; s[1] = v[i][1]; s[2] = v[i][2]; s[3] = v[i][3]; }
  } else {
#pragma unroll 8
    for (int i = 0; i < 32; ++i) { const int kk = 2 * i + (lane >> 5); scr[kk * 33 + (lane & 31)] = 0.f; }
  }
  WAVE_LDS_FENCE();
  const int c = lane & 7;
#pragma unroll
  for (int j = 0; j < 4; ++j) { const int n = (lane >> 3) + 8 * j; const float* s = scr + (8 * c) * 33 + n;
    u32x4 o; o[0] = pk2(s[0 * 33], s[1 * 33]); o[1] = pk2(s[2 * 33], s[3 * 33]); o[2] = pk2(s[4 * 33], s[5 * 33]); o[3] = pk2(s[6 * 33], s[7 * 33]);
    *(u32x4*)(WT + (size_t)(nrow0 + n) * K + kd0 + 8 * c) = o; }
  WAVE_LDS_FENCE();
}
__device__ __forceinline__ void p0_phase(const Params& P, unsigned char* lds, int bid, int G, int tid, int wid, int lane) {
  unsigned char* ws = P.ws;
  float* red = (float*)lds; float* sc = (float*)(lds + 4096);
  if (bid < 192) { for (int k = tid; k < DM; k += 512) sc[k] = silu_f(P.c[k]); __syncthreads(); }
  for (int item = bid; item < 192; item += G) {
    const int layer = item / 96, cgi = item % 96;
    const float* W = layer ? P.o_ada_w : P.e_ada_w; const float* bias = layer ? P.o_ada_b : P.e_ada_b;
    f32x4 a4 = {0.f, 0.f, 0.f, 0.f}; const int k0 = wid * 256 + (lane >> 4), c4 = cgi * 64 + (lane & 15) * 4;
#pragma unroll 8
    for (int k = 0; k < 256; k += 4) a4 += *(const f32x4*)(W + (size_t)(k0 + k) * 6144 + c4) * sc[k0 + k];
#pragma unroll
    for (int e = 0; e < 4; ++e) { a4[e] += __shfl_xor(a4[e], 16); a4[e] += __shfl_xor(a4[e], 32); }
    if (lane < 16) *(f32x4*)(red + wid * 64 + lane * 4) = a4;
    __syncthreads();
    if (tid < 64) { float s = 0.f;
#pragma unroll
      for (int i = 0; i < 8; ++i) s += red[i * 64 + tid];
      ((float*)(ws + O_MOD))[layer * 6144 + cgi * 64 + tid] = s + bias[cgi * 64 + tid]; }
    __syncthreads();
  }
  float* scr = (float*)(lds + 16384 + wid * 8448);
  const int gw = bid * 8 + wid, ngw = G * 8;
  constexpr int I0 = 32 * 144;
  for (int it = gw; it < I0; it += ngw) {
    int r = it;
    if (r < I0) { const int kb = r / 144, nb = r % 144; p0_transpose_item(P.e_w_in, 4608, 2048, (bf16_t*)(ws + O_WT_IN_E), 64 * kb, 32 * nb, 32 * nb, scr, lane); continue; } r -= I0;
  }
  for (int i = bid * 512 + tid; i < L + 6912; i += G * 512) { if (i < L) ((float*)(ws + O_SSQ1))[i] = 0.f; else ((float*)(ws + O_SWO))[i - L] = 0.f; }
  for (int idx = bid * 512 + tid; idx < 2 * 64 * 64; idx += G * 512) {
    const int dg = idx >> 6, p = idx & 63;
    const float lr = P.s5_lam_re[idx], li = P.s5_lam_im[idx], dt = __expf(P.s5_log_step[dg]);
    const float mag = __expf(lr * dt); float sn, cs; sincos_rev(li * dt, sn, cs);
    const float abr = mag * cs, abi = mag * sn, den = lr * lr + li * li, nr = abr - 1.f;
    const float fr = (nr * lr + abi * li) / den, fi = (abi * lr - nr * li) / den;
    float* ab = (float*)(ws + O_AB); ab[idx * 2] = abr; ab[idx * 2 + 1] = abi;
    bf16_t* bbar = (bf16_t*)(ws + O_BBAR); bf16_t* cmat = (bf16_t*)(ws + O_CMAT);
    for (int i = 0; i < 16; ++i) { const float br = P.s5_b_re[(size_t)idx * 16 + i], bi = P.s5_b_im[(size_t)idx * 16 + i];
      bbar[((size_t)dg * 128 + p) * 16 + i] = f2bf(fr * br - fi * bi); bbar[((size_t)dg * 128 + 64 + p) * 16 + i] = f2bf(fr * bi + fi * br); }
    for (int ch = 0; ch < 16; ++ch) { const float cr = P.s5_c_re[((size_t)dg * 16 + ch) * 64 + p], ci = P.s5_c_im[((size_t)dg * 16 + ch) * 64 + p];
      cmat[((size_t)dg * 16 + ch) * 128 + p] = f2bf(cr); cmat[((size_t)dg * 16 + ch) * 128 + 64 + p] = f2bf(-ci); }
  }
}
__device__ __forceinline__ void w_in_o_phase(const Params& P, unsigned char* lds, int gw, int ngw, int wid, int lane) {
  const float* mod1 = (const float*)(P.ws + O_MOD) + 6144; float* sW = (float*)(P.ws + O_SWO);
  const float* W = P.o_w_in; bf16_t* WT = (bf16_t*)(P.ws + O_WT_IN_O); constexpr int N = 6688, K = 2048;
  float* scr = (float*)(lds + 16384 + wid * 8448);
  for (int it = gw; it < 32 * 216; it += ngw) {
    const int kb = it / 216, nb = it % 216, k0 = 64 * kb, n0 = 32 * nb;
    if (n0 < N) {
      f32x4 v[8]; f32x4 ps = {0.f, 0.f, 0.f, 0.f};
#pragma unroll
      for (int i = 0; i < 8; ++i) v[i] = *(const f32x4*)(W + (size_t)(k0 + 8 * i + (lane >> 3)) * N + n0 + (lane & 7) * 4);
#pragma unroll
      for (int i = 0; i < 8; ++i) { const int k = k0 + 8 * i + (lane >> 3); const float sh = mod1[k], a = P.o_norm_g[k] * (1.f + mod1[2048 + k]);
        ps += v[i] * sh; v[i] *= a; }
#pragma unroll
      for (int e = 0; e < 4; ++e) { ps[e] += __shfl_xor(ps[e], 8); ps[e] += __shfl_xor(ps[e], 16); ps[e] += __shfl_xor(ps[e], 32); }
      if ((lane >> 3) == 0) {
#pragma unroll
        for (int e = 0; e < 4; ++e) atomicAdd(sW + n0 + (lane & 7) * 4 + e, ps[e]); }
#pragma unroll
      for (int i = 0; i < 8; ++i) { float* s = scr + (8 * i + (lane >> 3)) * 33 + (lane & 7) * 4; s[0] = v[i][0]; s[1] = v[i][1]; s[2] = v[i][2]; s[3] = v[i][3]; }
    } else {
#pragma unroll 8
      for (int i = 0; i < 32; ++i) { const int kk = 2 * i + (lane >> 5); scr[kk * 33 + (lane & 31)] = 0.f; }
    }
    WAVE_LDS_FENCE();
    const int c = lane & 7;
#pragma unroll
    for (int j = 0; j < 4; ++j) { const int n = (lane >> 3) + 8 * j; const float* s = scr + (8 * c) * 33 + n;
      u32x4 o; o[0] = pk2(s[0 * 33], s[1 * 33]); o[1] = pk2(s[2 * 33], s[3 * 33]); o[2] = pk2(s[4 * 33], s[5 * 33]); o[3] = pk2(s[6 * 33], s[7 * 33]);
      *(u32x4*)(WT + (size_t)(n0 + n) * K + k0 + 8 * c) = o; }
    WAVE_LDS_FENCE();
  }
}
__device__ __forceinline__ void gemm_tail_fill(const Params& P, unsigned char* lds, int wv, int nwv, int wid, int lane) {
  unsigned char* ws = P.ws; float* scr = (float*)(lds + 16384 + wid * 8448);
  constexpr int I1 = 16 * 64, I2 = 32 * 64, I4 = 32 * 64;
  for (int it = wv; it < I1 + I2 + I4; it += nwv) {
    int r = it;
    if (r < I1) { const int kb = r / 64, nb = r % 64, n0 = 32 * nb, pn = n0 >> 8, bj = (n0 >> 7) & 1, j0 = n0 & 127;
                  p0_transpose_item(P.s5_w_glu, 2048, 1024, (bf16_t*)(ws + O_WT_GLU), 64 * kb, n0, 1024 * bj + 128 * pn + j0, scr, lane); continue; } r -= I1;
    if (r < I2) { const int kb = r / 64, nb = r % 64; p0_transpose_item(P.e_w_out, 2048, 2048, (bf16_t*)(ws + O_WT_OUT_E), 64 * kb, 32 * nb, 32 * nb, scr, lane); continue; } r -= I2;
    { const int kb = r / 64, nb = r % 64, k0 = 64 * kb;
      p0_transpose_item(P.o_w_out, 2048, 2048, (bf16_t*)(ws + O_WT_OUT_O), k0, 32 * nb, 32 * nb, scr, lane, (k0 + 1024) & 2047, k0 >= 1024 ? P.ssd_norm_w - 1024 : nullptr); }
  }
  w_in_o_phase(P, lds, wv, nwv, wid, lane);
}
__device__ __forceinline__ void norm_mod_phase(const float* __restrict__ X, const float* __restrict__ g, const float* __restrict__ mod, bf16_t* __restrict__ H, int gw, int ngw, int lane) {
  for (int row = gw; row < L; row += ngw) {
    const f32x4* xr = (const f32x4*)(X + (size_t)row * DM) + lane;
    f32x4 v[8]; float ss = 0.f;
#pragma unroll
    for (int j = 0; j < 8; ++j) { v[j] = xr[64 * j]; ss += v[j][0] * v[j][0] + v[j][1] * v[j][1] + v[j][2] * v[j][2] + v[j][3] * v[j][3]; }
    const float rstd = rsqrtf(wave_sum(ss) * (1.f / DM) + EPS);
#pragma unroll
    for (int j = 0; j < 8; ++j) { const int col = (lane + 64 * j) * 4;
      const f32x4 g4 = *(const f32x4*)(g + col), sh = *(const f32x4*)(mod + col), sc4 = *(const f32x4*)(mod + DM + col);
      f32x4 o = v[j] * rstd * g4 * (sc4 + 1.f) + sh;
      u32x2 w = {pk2(o[0], o[1]), pk2(o[2], o[3])};
      *(u32x2*)(H + (size_t)row * DM + col) = w; }
  }
}
__device__ __forceinline__ void kprep_gqa_phase(const Params& P, int gw, int ngw, int lane) {
  const bf16_t* kr = (const bf16_t*)(P.ws + O_KR); bf16_t* kn = (bf16_t*)(P.ws + O_KN);
  const int sub = lane & 15, rsel = lane >> 4;
  const f32x4 w0 = *(const f32x4*)(P.e_k_norm + sub * 8), w1 = *(const f32x4*)(P.e_k_norm + sub * 8 + 4);
  float inv[4];
#pragma unroll
  for (int e = 0; e < 4; ++e) inv[e] = exp2f(-(float)((sub * 4 + e) & 31) * (13.287712379549449f / 32.f));
  for (int r0 = gw * 16; r0 < L * 2; r0 += ngw * 16) {
    u32x4 w[4];
#pragma unroll
    for (int k = 0; k < 4; ++k) w[k] = *(const u32x4*)(kr + (size_t)(r0 + k * 4 + rsel) * 128 + sub * 8);
#pragma unroll
    for (int k = 0; k < 4; ++k) { const int row = r0 + k * 4 + rsel, tok = row >> 1; float v[8]; float ss = 0.f;
#pragma unroll
      for (int e = 0; e < 4; ++e) { v[2 * e] = lo2f(w[k][e]); v[2 * e + 1] = hi2f(w[k][e]); ss += v[2 * e] * v[2 * e] + v[2 * e + 1] * v[2 * e + 1]; }
      ss += __shfl_xor(ss, 1); ss += __shfl_xor(ss, 2); ss += __shfl_xor(ss, 4); ss += __shfl_xor(ss, 8);
      const float rstd = rsqrtf(ss * (1.f / 128.f) + EPS);
      v[0] *= rstd * w0[0]; v[1] *= rstd * w0[1]; v[2] *= rstd * w0[2]; v[3] *= rstd * w0[3]; v[4] *= rstd * w1[0]; v[5] *= rstd * w1[1]; v[6] *= rstd * w1[2]; v[7] *= rstd * w1[3];
      const float pos = sub < 8 ? (float)(tok >> 6) : (float)(tok & 63);
      u32x4 o;
#pragma unroll
      for (int e = 0; e < 4; ++e) { float sn, cs; sincos_rev(pos * inv[e], sn, cs); o[e] = pk2(v[2 * e] * cs - v[2 * e + 1] * sn, v[2 * e] * sn + v[2 * e + 1] * cs); }
      *(u32x4*)(kn + (size_t)row * 128 + sub * 8) = o; }
  }
}
template <bool PASS2, int DIR>
__device__ __forceinline__ void s5_sub(const bf16x8 ufr, const bf16x8 (&bfr)[8], const bf16x8 (&cfr)[4], float ar, float ai, float& hr, float& hi, f32x4& ya,
                                       float* XS, bf16_t* HS, int lane) {
  const int n = lane & 15, kq = lane >> 4;
  const bf16x8 zero8 = {0, 0, 0, 0, 0, 0, 0, 0}; const f32x4 zero4 = {0.f, 0.f, 0.f, 0.f};
#pragma unroll
  for (int jt = 0; jt < 8; ++jt) { const f32x4 xv = mfma16(ufr, bfr[jt], zero4);
#pragma unroll
    for (int r = 0; r < 4; ++r) XS[(kq * 4 + r) * 132 + jt * 16 + n] = xv[r]; }
  WAVE_LDS_FENCE();
  float xr_[16], xi_[16];
#pragma unroll
  for (int tt = 0; tt < 16; ++tt) { const int t = DIR ? 15 - tt : tt; xr_[tt] = XS[t * 132 + lane]; xi_[tt] = XS[t * 132 + 64 + lane]; }
  WAVE_LDS_FENCE(); __builtin_amdgcn_sched_barrier(0);
#pragma unroll
  for (int tt = 0; tt < 16; ++tt) { const int t = DIR ? 15 - tt : tt; const float xr = xr_[tt], xi = xi_[tt];
    const float nr = ar * hr - ai * hi + xr, ni = ar * hi + ai * hr + xi; hr = nr; hi = ni;
    if (PASS2) { const unsigned pk = pk2(hr, hi); HS[t * 136 + lane] = (bf16_t)(pk & 0xffffu); HS[t * 136 + 64 + lane] = (bf16_t)(pk >> 16); } }
  WAVE_LDS_FENCE();
  if (PASS2) {
    bf16x8 ha[4];
#pragma unroll
    for (int ks = 0; ks < 4; ++ks) ha[ks] = *(const bf16x8*)(HS + n * 136 + ks * 32 + kq * 8);
#pragma unroll
    for (int ks = 0; ks < 4; ++ks) ya = mfma16(ha[ks], cfr[ks], ya);
    WAVE_LDS_FENCE();
  }
}
template <bool PASS2, int DIR>
__device__ __forceinline__ void s5_dir(const Params& P, int c, int g, float* XS, bf16_t* HS, int lane, f32x4 (&yacc)[8], const bf16x8 (&ufr)[8]) {
  const int dg = DIR * 64 + g, n = lane & 15, kq = lane >> 4;
  const bf16_t* bbar = (const bf16_t*)(P.ws + O_BBAR); const bf16_t* cmat = (const bf16_t*)(P.ws + O_CMAT); const float* ab = (const float*)(P.ws + O_AB);
  const bf16_t* U = (const bf16_t*)(P.ws + O_RA + 2 * SZ_LK); float* s5e = (float*)(P.ws + O_S5E);
  const bf16x8 zero8 = {0, 0, 0, 0, 0, 0, 0, 0}; const f32x4 zero4 = {0.f, 0.f, 0.f, 0.f};
  bf16x8 bfr[8];
#pragma unroll
  for (int jt = 0; jt < 8; ++jt) { bfr[jt] = zero8; if (kq < 2) bfr[jt] = *(const bf16x8*)(bbar + ((size_t)dg * 128 + jt * 16 + n) * 16 + kq * 8); }
  const float ar = ab[(dg * 64 + lane) * 2], ai = ab[(dg * 64 + lane) * 2 + 1];
  float hr = 0.f, hi = 0.f;
  bf16x8 cfr[4] = {zero8, zero8, zero8, zero8};
  if (PASS2) {
#pragma unroll
    for (int ks = 0; ks < 4; ++ks) cfr[ks] = *(const bf16x8*)(cmat + ((size_t)dg * 16 + n) * 128 + ks * 32 + kq * 8);
    float tr = ar, ti = ai;
#pragma unroll
    for (int i = 0; i < 7; ++i) { const float nr = tr * tr - ti * ti, ni = 2.f * tr * ti; tr = nr; ti = ni; }
    { const float* e = s5e + ((size_t)(c * 64 + g) * 2 + DIR) * 128; hr = e[lane]; hi = e[64 + lane]; }
  }
  f32x4 dummy = zero4;
#pragma unroll
  for (int s = 0; s < 8; ++s) { const int sb = DIR ? 7 - s : s;
    s5_sub<PASS2, DIR>(ufr[sb], bfr, cfr, ar, ai, hr, hi, PASS2 ? yacc[sb] : dummy, XS, HS, lane);
    __builtin_amdgcn_sched_barrier(0); }
  if (!PASS2) { float* e = s5e + ((size_t)(c * 64 + g) * 2 + DIR) * 128; e[lane] = hr; e[64 + lane] = hi; }
}
__device__ __forceinline__ void s5_carry_phase(const Params& P, int bid, int G, int wid, int lane) {
  float* s5e = (float*)(P.ws + O_S5E); const float* ab = (const float*)(P.ws + O_AB);
  if (wid != 0) return;
  for (int seq = bid; seq < 128; seq += G) {
    const int g = seq & 63, dir = seq >> 6, dg = dir * 64 + g;
    float tr = ab[(dg * 64 + lane) * 2], ti = ab[(dg * 64 + lane) * 2 + 1];
#pragma unroll
    for (int i = 0; i < 7; ++i) { const float nr = tr * tr - ti * ti, ni = 2.f * tr * ti; tr = nr; ti = ni; }
    float hr = 0.f, hi = 0.f;
#pragma unroll 1
    for (int ib = 0; ib < NCH; ib += 16) { float er[16], ei[16];
#pragma unroll
      for (int k = 0; k < 16; ++k) { const int c = dir ? NCH - 1 - (ib + k) : ib + k; const float* e = s5e + ((size_t)(c * 64 + g) * 2 + dir) * 128; er[k] = e[lane]; ei[k] = e[64 + lane]; }
#pragma unroll
      for (int k = 0; k < 16; ++k) { const int c = dir ? NCH - 1 - (ib + k) : ib + k; float* e = s5e + ((size_t)(c * 64 + g) * 2 + dir) * 128;
        e[lane] = hr; e[64 + lane] = hi;
        const float nr = tr * hr - ti * hi + er[k], ni = tr * hi + ti * hr + ei[k]; hr = nr; hi = ni; }
    }
  }
}
template <bool PASS2>
__device__ __forceinline__ void s5_phase(const Params& P, unsigned char* lds, int gw, int ngw, int wid, int lane) {
  float* XS = (float*)(lds + wid * 8448); bf16_t* HS = (bf16_t*)(lds + 8 * 8448 + wid * 4352);
  const bf16_t* U = (const bf16_t*)(P.ws + O_RA + 2 * SZ_LK); bf16_t* Y = (bf16_t*)(P.ws + O_Y);
  for (int task = gw; task < NCH * 64; task += ngw) {
    const int c = task >> 6, g = task & 63;
    f32x4 yacc[8];
#pragma unroll
    for (int i = 0; i < 8; ++i) yacc[i] = (f32x4){0.f, 0.f, 0.f, 0.f};
    bf16x8 ufr[8];
#pragma unroll
    for (int sb = 0; sb < 8; ++sb) { ufr[sb] = (bf16x8){0, 0, 0, 0, 0, 0, 0, 0};
      if ((lane >> 4) < 2) ufr[sb] = *(const bf16x8*)(U + (size_t)(c * 128 + sb * 16 + (lane & 15)) * 1024 + g * 16 + (lane >> 4) * 8); }
    s5_dir<PASS2, 0>(P, c, g, XS, HS, lane, yacc, ufr);
    s5_dir<PASS2, 1>(P, c, g, XS, HS, lane, yacc, ufr);
    if (PASS2) {
      const int n = lane & 15, kq = lane >> 4, ch = g * 16 + n; const float dd = P.s5_d[ch];
#pragma unroll
      for (int sb = 0; sb < 8; ++sb)
#pragma unroll
        for (int r = 0; r < 4; ++r) { const size_t t = (size_t)c * 128 + sb * 16 + kq * 4 + r;
          const float y = yacc[sb][r] + dd * bf2f(U[t * 1024 + ch]);
          const float z = 0.7978845608028654f * (y + 0.044715f * y * y * y);
          const float th = 1.f - 2.f * __builtin_amdgcn_rcpf(1.f + __expf(2.f * z));
          Y[t * 1024 + ch] = f2bf(0.5f * y * (1.f + th)); }
    }
  }
}
__device__ __forceinline__ void prep1_phase(const Params& P, unsigned char* lds, int gw, int ngw, int wid, int lane, bool do_knorm) {
  unsigned char* ws = P.ws;
  if (do_knorm) { bf16_t* K = (bf16_t*)(ws + O_RA + SZ_LK); const int sub = lane & 15, rsel = lane >> 4;
    const f32x4 w0 = *(const f32x4*)(P.o_k_norm + sub * 8), w1 = *(const f32x4*)(P.o_k_norm + sub * 8 + 4);
    for (int r0 = gw * 16; r0 < L * 8; r0 += ngw * 16) {
      u32x4 w[4];
#pragma unroll
      for (int k = 0; k < 4; ++k) w[k] = *(const u32x4*)(K + (size_t)(r0 + k * 4 + rsel) * 128 + sub * 8);
#pragma unroll
      for (int k = 0; k < 4; ++k) { float v[8]; float ss = 0.f;
#pragma unroll
        for (int e = 0; e < 4; ++e) { v[2 * e] = lo2f(w[k][e]); v[2 * e + 1] = hi2f(w[k][e]); ss += v[2 * e] * v[2 * e] + v[2 * e + 1] * v[2 * e + 1]; }
        ss += __shfl_xor(ss, 1); ss += __shfl_xor(ss, 2); ss += __shfl_xor(ss, 4); ss += __shfl_xor(ss, 8);
        const float rstd = rsqrtf(ss * (1.f / 128.f) + EPS);
        u32x4 o; o[0] = pk2(v[0] * rstd * w0[0], v[1] * rstd * w0[1]); o[1] = pk2(v[2] * rstd * w0[2], v[3] * rstd * w0[3]);
        o[2] = pk2(v[4] * rstd * w1[0], v[5] * rstd * w1[1]); o[3] = pk2(v[6] * rstd * w1[2], v[7] * rstd * w1[3]);
        *(u32x4*)(K + (size_t)(r0 + k * 4 + rsel) * 128 + sub * 8) = o; } } }
  { const bf16_t* xr = (const bf16_t*)(ws + O_XBCR); bf16_t* xc = (bf16_t*)(ws + O_XBCC); bf16_t* xt = (bf16_t*)(ws + O_XBCT);
    bf16_t* RAW = (bf16_t*)(lds + wid * 17920); bf16_t* TS = RAW + 68 * 64;
    for (int it = gw; it < 256 * 24; it += ngw) {
      const int tb = it / 24, cb = it % 24, t0 = tb * 64, ch = cb * 64 + lane;
#pragma unroll
      for (int i = 0; i < 9; ++i) { const int id = lane + 64 * i;
        if (id < 544) { const int r = id >> 3, cc = id & 7, t = t0 - 2 + r; u32x4 v = {0u, 0u, 0u, 0u};
          if (t >= 0 && t < L) v = *(const u32x4*)(xr + (size_t)t * 1536 + cb * 64 + cc * 8);
          *(u32x4*)(RAW + r * 64 + cc * 8) = v; } }
      const float w0 = P.ssd_conv_w[0 * 1536 + ch], w1 = P.ssd_conv_w[1 * 1536 + ch], w2 = P.ssd_conv_w[2 * 1536 + ch], w3 = P.ssd_conv_w[3 * 1536 + ch], w4 = P.ssd_conv_w[4 * 1536 + ch];
      const float cb_ = P.ssd_conv_b[ch];
      WAVE_LDS_FENCE();
      float a0 = bf2f(RAW[0 * 64 + lane]), a1 = bf2f(RAW[1 * 64 + lane]), a2 = bf2f(RAW[2 * 64 + lane]), a3 = bf2f(RAW[3 * 64 + lane]);
#pragma unroll 1
      for (int i0 = 0; i0 < 64; i0 += 8) { float nx[8];
#pragma unroll
        for (int k = 0; k < 8; ++k) nx[k] = bf2f(RAW[(i0 + k + 4) * 64 + lane]);
#pragma unroll
        for (int k = 0; k < 8; ++k) { const float a4 = nx[k];
          const float v = silu_f(w0 * a0 + w1 * a1 + w2 * a2 + w3 * a3 + w4 * a4 + cb_);
          const bf16_t b = f2bf(v); RAW[(i0 + k) * 64 + lane] = b; TS[lane * 72 + i0 + k] = b;
          a0 = a1; a1 = a2; a2 = a3; a3 = a4; } }
      WAVE_LDS_FENCE();
      if (cb >= 16) {
#pragma unroll
        for (int j = 0; j < 8; ++j) { const int id = lane + 64 * j, r = id >> 3, cc = id & 7;
          *(u32x4*)(xc + (size_t)(t0 + r) * 1536 + cb * 64 + cc * 8) = *(const u32x4*)(RAW + r * 64 + cc * 8); } }
      if (cb < 20) {
#pragma unroll
        for (int j = 0; j < 8; ++j) { const int r = (lane >> 3) + 8 * j, cc = lane & 7;
          *(u32x4*)(xt + (size_t)(cb * 64 + r) * L + t0 + cc * 8) = *(const u32x4*)(TS + r * 72 + cc * 8); } }
      WAVE_LDS_FENCE();
    } }
  { const float* dtr = (const float*)(ws + O_DTR); float* dt = (float*)(ws + O_DT); float* cum = (float*)(ws + O_CUM); float* tot = (float*)(ws + O_TOT);
    __syncthreads();
    float* A = (float*)(lds + wid * 16896);
    for (int c = gw; c < NCH; c += ngw) {
      const int col4 = (lane & 7) * 4; f32x4 bb, aa;
#pragma unroll
      for (int e = 0; e < 4; ++e) { bb[e] = P.ssd_dt_bias[col4 + e]; aa[e] = -__expf(P.ssd_a_log[col4 + e]); }
#pragma unroll 4
      for (int i = 0; i < 16; ++i) { const int t = i * 8 + (lane >> 3);
        const f32x4 v = *(const f32x4*)(dtr + ((size_t)c * 128 + t) * 32 + col4); f32x4 d;
#pragma unroll
        for (int e = 0; e < 4; ++e) { const float x = v[e] + bb[e]; d[e] = x > 20.f ? x : log1pf(__expf(x)); A[t * 33 + col4 + e] = d[e] * aa[e]; }
        *(f32x4*)(dt + ((size_t)c * 128 + t) * 32 + col4) = d; }
      WAVE_LDS_FENCE();
      if (lane < 32) { float cs = 0.f;
#pragma unroll 8
        for (int i = 0; i < 128; ++i) { const int t = lane < 16 ? i : 127 - i; cs += A[t * 33 + lane]; A[t * 33 + lane] = cs; }
        tot[c * 32 + lane] = cs; }
      WAVE_LDS_FENCE();
#pragma unroll 4
      for (int i = 0; i < 16; ++i) { const int t = i * 8 + (lane >> 3); f32x4 o;
#pragma unroll
        for (int e = 0; e < 4; ++e) o[e] = A[t * 33 + col4 + e];
        *(f32x4*)(cum + ((size_t)c * 128 + t) * 32 + col4) = o; }
      WAVE_LDS_FENCE();
    } }
}
__device__ __forceinline__ void ssd1_phase(const Params& P, unsigned char* lds, int bid, int G, int tid, int wid, int lane) {
  unsigned char* ws = P.ws;
  const bf16_t* xt = (const bf16_t*)(ws + O_XBCT); const float* dt = (const float*)(ws + O_DT); const float* cum = (const float*)(ws + O_CUM);
  bf16_t* ST = (bf16_t*)P.out;
  bf16_t* BT = (bf16_t*)lds; bf16_t* XF = (bf16_t*)(lds + 34816); bf16_t* XB = (bf16_t*)(lds + 34816 + 17408); float* wFa = (float*)(lds + 34816 + 2 * 17408); float* wBa = wFa + 8 * 128;
  for (int u = bid; u < NCH * 2; u += G) {
    const int c = u >> 1, gr = u & 1;
    __syncthreads();
#pragma unroll
    for (int i = 0; i < 4; ++i) { const int ch = tid + 512 * i, r = ch >> 4, cc = ch & 15;
      *(u32x4*)(BT + r * 136 + cc * 8) = *(const u32x4*)(xt + (size_t)(1024 + gr * 128 + r) * L + c * 128 + cc * 8); }
    { const int l = tid & 127, hq = tid >> 7; const size_t t = (size_t)c * 128 + l;
#pragma unroll
      for (int k = 0; k < 2; ++k) { const int hh = hq + 4 * k, h = gr * 8 + hh;
        wFa[hh * 128 + l] = dt[t * 32 + h] * __expf(cum[((size_t)c * 128 + 127) * 32 + h] - cum[t * 32 + h]);
        wBa[hh * 128 + l] = dt[t * 32 + 16 + h] * __expf(cum[((size_t)c * 128) * 32 + 16 + h] - cum[t * 32 + 16 + h]); } }
    __syncthreads();
    u32x4 wx[2];
#pragma unroll
    for (int i = 0; i < 2; ++i) { const int ch = tid + 512 * i, r = ch >> 4, cc = ch & 15; wx[i] = *(const u32x4*)(xt + (size_t)(gr * 8 * 64 + r) * L + c * 128 + cc * 8); }
#pragma unroll 1
    for (int hh = 0; hh < 8; ++hh) {
      const int h = gr * 8 + hh;
      const float* wF = wFa + hh * 128; const float* wB = wBa + hh * 128;
#pragma unroll
      for (int i = 0; i < 2; ++i) { const int ch = tid + 512 * i, r = ch >> 4, cc = ch & 15;
        const u32x4 w = wx[i];
        u32x4 of, ob;
#pragma unroll
        for (int e = 0; e < 4; ++e) { const float x0 = lo2f(w[e]), x1 = hi2f(w[e]); const int l0 = cc * 8 + 2 * e;
          of[e] = pk2(x0 * wF[l0], x1 * wF[l0 + 1]); ob[e] = pk2(x0 * wB[l0], x1 * wB[l0 + 1]); }
        *(u32x4*)(XF + r * 136 + cc * 8) = of; *(u32x4*)(XB + r * 136 + cc * 8) = ob; }
      __syncthreads();
      if (hh + 1 < 8) {
#pragma unroll
        for (int i = 0; i < 2; ++i) { const int ch = tid + 512 * i, r = ch >> 4, cc = ch & 15; wx[i] = *(const u32x4*)(xt + (size_t)((h + 1) * 64 + r) * L + c * 128 + cc * 8); } }
      { const int dir = wid >> 2, pt = wid & 3; const bf16_t* XS = dir ? XB : XF;
        f32x4 acc[8];
#pragma unroll
        for (int i = 0; i < 8; ++i) acc[i] = (f32x4){0.f, 0.f, 0.f, 0.f};
#pragma unroll
        for (int ks = 0; ks < 4; ++ks) { const bf16x8 a = ldfrag(XS, 136, 16 * pt, ks * 32, lane); bf16x8 bb[8];
#pragma unroll
          for (int nt = 0; nt < 8; ++nt) bb[nt] = ldfrag(BT, 136, 16 * nt, ks * 32, lane);
#pragma unroll
          for (int nt = 0; nt < 8; ++nt) acc[nt] = mfma16(a, bb[nt], acc[nt]); }
        bf16_t* dst = ST + (((size_t)c * 16 + h) * 2 + dir) * 8192;
#pragma unroll
        for (int nt = 0; nt < 8; ++nt)
#pragma unroll
          for (int r = 0; r < 4; ++r) dst[(16 * pt + (lane >> 4) * 4 + r) * 128 + 16 * nt + (lane & 15)] = f2bf(acc[nt][r]); }
      __syncthreads();
    }
  }
}
__device__ __forceinline__ void ssd_carry_phase(const Params& P, int bid, int G, int tid) {
  bf16_t* ST = (bf16_t*)P.out; const float* tot = (const float*)(P.ws + O_TOT);
  for (int e2 = bid * 512 + tid; e2 < 16 * 2 * 8192 / 2; e2 += G * 512) {
    const int e = e2 * 2, h = e >> 14, dir = (e >> 13) & 1;
    float r0 = 0.f, r1 = 0.f;
#pragma unroll 1
    for (int ib = 0; ib < NCH; ib += 16) {
      unsigned w[16]; float dec[16];
#pragma unroll
      for (int k = 0; k < 16; ++k) { const int c = dir ? NCH - 1 - (ib + k) : ib + k;
        w[k] = *(const unsigned*)(ST + (size_t)c * 262144 + e); dec[k] = tot[c * 32 + dir * 16 + h]; }
#pragma unroll
      for (int k = 0; k < 16; ++k) { const int c = dir ? NCH - 1 - (ib + k) : ib + k;
        *(unsigned*)(ST + (size_t)c * 262144 + e) = pk2(r0, r1);
        const float d = __expf(dec[k]); r0 = r0 * d + lo2f(w[k]); r1 = r1 * d + hi2f(w[k]); }
    }
  }
}
__device__ __forceinline__ void ssd2_phase(const Params& P, unsigned char* lds, int bid, int G, int tid, int wid, int lane) {
  unsigned char* ws = P.ws;
  const bf16_t* xc = (const bf16_t*)(ws + O_XBCC); const bf16_t* xt = (const bf16_t*)(ws + O_XBCT); const bf16_t* zs = (const bf16_t*)(ws + O_ZS);
  const float* dt = (const float*)(ws + O_DT); const float* cum = (const float*)(ws + O_CUM); const bf16_t* ST = (const bf16_t*)P.out;
  bf16_t* oc = (bf16_t*)(ws + O_OA); float* ssq = (float*)(ws + O_SSQ);
  bf16_t* Cs = (bf16_t*)lds; bf16_t* Bs = (bf16_t*)(lds + 34816); bf16_t* XT = (bf16_t*)(lds + 2 * 34816); bf16_t* Sf = (bf16_t*)(lds + 2 * 34816 + 17408);
  bf16_t* Sb = (bf16_t*)(lds + 2 * 34816 + 2 * 17408); float* cF = (float*)(lds + 2 * 34816 + 3 * 17408); float* dF = cF + 128; float* cB = cF + 256; float* dB = cF + 384;
  bf16_t* ZT = (bf16_t*)(lds + 2 * 34816 + 3 * 17408 + 2048);
  bf16_t* Ms = Bs + wid * 16 * 136;
  const int n = lane & 15, kq = lane >> 4;
  for (int u = bid; u < NCH * 2; u += G) {
    const int c = u >> 1, gr = u & 1;
    __syncthreads();
#pragma unroll
    for (int i = 0; i < 4; ++i) { const int ch = tid + 512 * i, r = ch >> 4, cc = ch & 15; const size_t t = (size_t)c * 128 + r;
      *(u32x4*)(Bs + r * 136 + cc * 8) = *(const u32x4*)(xc + t * 1536 + 1024 + gr * 128 + cc * 8);
      *(u32x4*)(Cs + r * 136 + cc * 8) = *(const u32x4*)(xc + t * 1536 + 1280 + gr * 128 + cc * 8); }
    __syncthreads();
    bf16x8 ca[4]; f32x4 gacc[8];
#pragma unroll
    for (int ks = 0; ks < 4; ++ks) ca[ks] = ldfrag(Cs, 136, 16 * wid, ks * 32, lane);
#pragma unroll
    for (int tc = 0; tc < 8; ++tc) { gacc[tc] = (f32x4){0.f, 0.f, 0.f, 0.f};
#pragma unroll
      for (int ks = 0; ks < 4; ++ks) gacc[tc] = mfma16(ca[ks], ldfrag(Bs, 136, 16 * tc, ks * 32, lane), gacc[tc]); }
    u32x4 px[2], pf[2], pb[2], pz[2]; float pc0 = 0.f, pc1 = 0.f, pc2 = 0.f, pc3 = 0.f;
    float sqh[4] = {0.f, 0.f, 0.f, 0.f};
#define SSD2_FETCH(H) do { _Pragma("unroll") for (int i = 0; i < 2; ++i) { const int ch = tid + 512 * i, r = ch >> 4, cc = ch & 15; \
        px[i] = *(const u32x4*)(xt + (size_t)((H) * 64 + r) * L + c * 128 + cc * 8); \
        pf[i] = *(const u32x4*)(ST + (((size_t)c * 16 + (H)) * 2 + 0) * 8192 + r * 128 + cc * 8); \
        pb[i] = *(const u32x4*)(ST + (((size_t)c * 16 + (H)) * 2 + 1) * 8192 + r * 128 + cc * 8); \
        pz[i] = *(const u32x4*)(zs + ((size_t)c * 128 + (ch >> 3)) * 1024 + (H) * 64 + (ch & 7) * 8); } \
      if (tid < 128) { const size_t t = (size_t)c * 128 + tid; pc0 = cum[t * 32 + (H)]; pc1 = dt[t * 32 + (H)]; pc2 = cum[t * 32 + 16 + (H)]; pc3 = dt[t * 32 + 16 + (H)]; } } while (0)
    SSD2_FETCH(gr * 8);
#pragma unroll 1
    for (int hh = 0; hh < 8; ++hh) {
      const int h = gr * 8 + hh;
      __syncthreads();
#pragma unroll
      for (int i = 0; i < 2; ++i) { const int ch = tid + 512 * i, r = ch >> 4, cc = ch & 15;
        *(u32x4*)(XT + r * 136 + cc * 8) = px[i]; *(u32x4*)(Sf + r * 136 + cc * 8) = pf[i]; *(u32x4*)(Sb + r * 136 + cc * 8) = pb[i];
        *(u32x4*)(ZT + (ch >> 3) * 72 + (ch & 7) * 8) = pz[i]; }
      if (tid < 128) { cF[tid] = pc0; dF[tid] = pc1; cB[tid] = pc2; dB[tid] = pc3; }
      __syncthreads();
      if (hh + 1 < 8) SSD2_FETCH(h + 1);
      f32x4 yacc[4];
#pragma unroll
      for (int i = 0; i < 4; ++i) yacc[i] = (f32x4){0.f, 0.f, 0.f, 0.f};
#pragma unroll 1
      for (int dir = 0; dir < 2; ++dir) {
        const float* cu = dir ? cB : cF; const float* dd = dir ? dB : dF; const bf16_t* S = dir ? Sb : Sf;
        int nn = n; asm volatile("" : "+v"(nn));
        float cl[4];
#pragma unroll
        for (int r = 0; r < 4; ++r) cl[r] = cu[16 * wid + kq * 4 + r];
        float cs8[8], ds8[8];
#pragma unroll
        for (int tc = 0; tc < 8; ++tc) { cs8[tc] = cu[16 * tc + n]; ds8[tc] = dd[16 * tc + n]; }
#pragma unroll
        for (int tc = 0; tc < 8; ++tc) { const int s_ = 16 * tc + n; const int rel = tc - wid;
          const bool full = dir ? (rel > 0) : (rel < 0);
          if (full || rel == 0) { const float cs_ = cs8[tc], ds_ = ds8[tc];
#pragma unroll
            for (int r = 0; r < 4; ++r) {
              float v = gacc[tc][r] * __expf(cl[r] - cs_) * ds_;
              if (!full) { const bool ok = dir ? (nn >= kq * 4 + r) : (nn <= kq * 4 + r); v = ok ? v : 0.f; }
              Ms[(kq * 4 + r) * 136 + s_] = f2bf(v); }
          } else {
#pragma unroll
            for (int r = 0; r < 4; ++r) Ms[(kq * 4 + r) * 136 + s_] = 0; } }
        WAVE_LDS_FENCE();
        f32x4 oacc[4];
#pragma unroll
        for (int pt = 0; pt < 4; ++pt) oacc[pt] = (f32x4){0.f, 0.f, 0.f, 0.f};
#pragma unroll
        for (int ks = 0; ks < 4; ++ks) { const bf16x8 ma = ldfrag(Ms, 136, 0, ks * 32, lane);
#pragma unroll
          for (int pt = 0; pt < 4; ++pt) { yacc[pt] = mfma16(ma, ldfrag(XT, 136, 16 * pt, ks * 32, lane), yacc[pt]);
            oacc[pt] = mfma16(ca[ks], ldfrag(S, 136, 16 * pt, ks * 32, lane), oacc[pt]); } }
        WAVE_LDS_FENCE();
#pragma unroll
        for (int r = 0; r < 4; ++r) { const float ed = __expf(cl[r]);
#pragma unroll
          for (int pt = 0; pt < 4; ++pt) yacc[pt][r] += oacc[pt][r] * ed; }
      }
      const float Dh = P.ssd_d[h];
#pragma unroll
      for (int r = 0; r < 4; ++r) { const size_t t = (size_t)c * 128 + 16 * wid + kq * 4 + r; float sq = 0.f;
#pragma unroll
        for (int pt = 0; pt < 4; ++pt) { const int col = h * 64 + 16 * pt + n;
          const int l_ = 16 * wid + kq * 4 + r, p_ = 16 * pt + n;
          const float y = (yacc[pt][r] + Dh * bf2f(XT[p_ * 136 + l_])) * bf2f(ZT[l_ * 72 + p_]);
          oc[t * 2048 + col] = f2bf(y); sq += y * y; }
        sq += __shfl_xor(sq, 1); sq += __shfl_xor(sq, 2); sq += __shfl_xor(sq, 4); sq += __shfl_xor(sq, 8);
        sqh[r] += sq; }
    }
    if (n == 0) {
#pragma unroll
      for (int r = 0; r < 4; ++r) ssq[((size_t)c * 128 + 16 * wid + kq * 4 + r) * 2 + gr] = sqh[r]; }
  }
}
#undef SSD2_FETCH
#ifndef SDG
#define SDG 2
#endif
#ifndef SDN
#define SDN 1
#endif
#ifndef PHG
#define PHG 0x1F
#endif
#ifndef GAL_SPLIT
#define GAL_SPLIT true
#endif
#ifndef GAL_GLU
#define GAL_GLU true
#endif
#ifndef GAL_RES
#define GAL_RES true
#endif
#ifndef GQA_HMAJOR
#define GQA_HMAJOR 1
#endif
#ifndef DUP
#define DUP 0
#endif
#define REP(k) for (int rep_ = 0; rep_ <= ((DUP >> (k)) & 1); ++rep_)
#define RSYNC if (rep_) __syncthreads();
#ifndef PH
#define PH 0xFFFF
#endif
__device__ __forceinline__ void gbar(unsigned* ctr, unsigned target, int tid) {
  __builtin_amdgcn_fence(__ATOMIC_RELEASE, "agent");
  asm volatile("s_waitcnt vmcnt(0) lgkmcnt(0)" ::: "memory");
  __syncthreads();
  if (tid == 0) {
    __hip_atomic_fetch_add(ctr, 1u, __ATOMIC_RELAXED, __HIP_MEMORY_SCOPE_AGENT);
    while (__hip_atomic_load(ctr, __ATOMIC_RELAXED, __HIP_MEMORY_SCOPE_AGENT) < target) __builtin_amdgcn_s_sleep(2);
  }
  __syncthreads();
  __builtin_amdgcn_fence(__ATOMIC_ACQUIRE, "agent");
  asm volatile("s_waitcnt vmcnt(0)" ::: "memory");
}
__device__ __forceinline__ Params load_params() {
#if defined(__HIP_DEVICE_COMPILE__)
  const __attribute__((address_space(4))) Params* pp = (const __attribute__((address_space(4))) Params*)__builtin_amdgcn_kernarg_segment_ptr();
  asm volatile("" : "+s"(pp));
  return *pp;
#else
  return Params{};
#endif
}
#define XB_TMO      128
#define XB_XCNT(j)  (256  + 64 * (j))
#define XB_XSUB(j)  (1280 + 64 * (j))
#define XB_XGEN(j)  (2304 + 64 * (j))
#define XB_TOP      3328
#define XB_TOPGEN   3392
#define XCD_BAR_WORDS 3456
#define XB_SPIN_CAP (1u << 18)
#define XB_LAS __attribute__((address_space(3)))
__device__ __forceinline__ unsigned xb_ld(unsigned* p)              { return __hip_atomic_load(p, __ATOMIC_RELAXED, __HIP_MEMORY_SCOPE_AGENT); }
__device__ __forceinline__ unsigned xb_add(unsigned* p, unsigned v) { return __hip_atomic_fetch_add(p, v, __ATOMIC_RELAXED, __HIP_MEMORY_SCOPE_AGENT); }
__device__ __forceinline__ unsigned xb_xcc_id() { return (unsigned)__builtin_amdgcn_s_getreg((3 << 11) | 20) & 0xFu; }
#define XB_SPIN(cond, bar) do { unsigned _sp = 0; while (cond) { __builtin_amdgcn_s_sleep(1); \
    if ((++_sp & 255u) == 0u) { if (xb_ld(&(bar)[XB_TMO])) break; if (_sp > XB_SPIN_CAP) { atomicAdd(&(bar)[XB_TMO], 1u); break; } } } } while (0)
struct XcdBarrier { unsigned* bar; unsigned x; volatile XB_LAS unsigned* st; };
__device__ __forceinline__ XcdBarrier xcd_barrier_post(unsigned* bar, volatile XB_LAS unsigned* st, int tid) {
  XcdBarrier b; b.bar = bar; b.x = xb_xcc_id(); b.st = st;
  if (tid == 0) (void)xb_add(&bar[XB_XCNT(b.x)], 1u);
  return b;
}
__device__ __forceinline__ void xcd_barrier_complete(unsigned* bar, unsigned x, unsigned& nloc, unsigned& nx, unsigned G) {
  unsigned sum, cnt, mine, sp = 0u;
  for (;;) {
    sum = 0u; cnt = 0u; mine = 0u;
#pragma unroll
    for (unsigned j = 0; j < 16; ++j) { const unsigned c = xb_ld(&bar[XB_XCNT(j)]); sum += c; cnt += (c > 0u) ? 1u : 0u; mine = (j == x) ? c : mine; }
    if (sum == G) break;
    __builtin_amdgcn_s_sleep(1);
    if ((++sp & 255u) == 0u) { if (xb_ld(&bar[XB_TMO])) break; if (sp > XB_SPIN_CAP) { atomicAdd(&bar[XB_TMO], 1u); break; } }
  }
  nloc = mine > 0u ? mine : 1u; nx = cnt > 0u ? cnt : 1u;
}
__device__ __forceinline__ void xcd_barrier(const XcdBarrier& b, int tid, unsigned G) {
  asm volatile("s_waitcnt vmcnt(0)" ::: "memory");
  __syncthreads();
  if (tid == 0) {
    unsigned* bar = b.bar;
    __builtin_amdgcn_s_waitcnt(0);
    unsigned nloc = b.st[0], nx = b.st[1];
    if (nloc == 0u) { xcd_barrier_complete(bar, b.x, nloc, nx, G); b.st[0] = nloc; b.st[1] = nx; }
    const unsigned old = xb_add(&bar[XB_XSUB(b.x)], 1u);
    const unsigned gen = old / nloc;
    if (old + 1u == (gen + 1u) * nloc) {
      __builtin_amdgcn_fence(__ATOMIC_RELEASE, "agent");
      asm volatile("s_waitcnt vmcnt(0)" ::: "memory");
      const unsigned og = xb_add(&bar[XB_TOP], 1u);
      const unsigned tg = og / nx;
      if (og + 1u == (tg + 1u) * nx) xb_add(&bar[XB_TOPGEN], 1u);
      else XB_SPIN(xb_ld(&bar[XB_TOPGEN]) == tg, bar);
      __builtin_amdgcn_fence(__ATOMIC_ACQUIRE, "agent");
      xb_add(&bar[XB_XGEN(b.x)], 1u);
      asm volatile("s_waitcnt vmcnt(0)" ::: "memory");
    } else {
      XB_SPIN(xb_ld(&bar[XB_XGEN(b.x)]) == gen, bar);
      __builtin_amdgcn_fence(__ATOMIC_ACQUIRE, "agent");
      asm volatile("s_waitcnt vmcnt(0)" ::: "memory");
    }
  }
  __syncthreads();
}
constexpr int LDS_BYTES = 147456;
__global__ __launch_bounds__(512, 2) void mega_fwd(Params Parg) {
  extern __shared__ __attribute__((aligned(16))) unsigned char shm[];
  cg::grid_group grid = cg::this_grid();
  const int G = gridDim.x, bid = blockIdx.x, ngw = G * 8;
  const int wid_s = __builtin_amdgcn_readfirstlane((int)threadIdx.x >> 6);
#define IDS unsigned z_ = 0u; asm volatile("" : "+v"(z_)); int tid_ = wid_s * 64 + (int)__builtin_amdgcn_mbcnt_hi(~0u, __builtin_amdgcn_mbcnt_lo(~0u, z_)); asm volatile("" : "+v"(tid_)); const int tid = tid_, wid = __builtin_amdgcn_readfirstlane(tid >> 6), lane = tid & 63, gw = bid * 8 + wid; (void)lane; (void)gw; (void)wid; \
  const Params P = load_params(); unsigned char* ws = P.ws; (void)ws; \
  const float* mod0 = (const float*)(ws + O_MOD); const float* mod1 = mod0 + 6144; (void)mod0; (void)mod1;
  PG8_LAS unsigned char* glds = (PG8_LAS unsigned char*)shm;
  unsigned* xbar = (unsigned*)(Parg.ws + O_BAR);
  volatile XB_LAS unsigned* xst = (volatile XB_LAS unsigned*)(shm + 147440);
  if (threadIdx.x == 0) { xst[0] = 0u; xst[1] = 0u; }
  if (bid == 0) { for (int i = threadIdx.x; i < XCD_BAR_WORDS; i += 512) xbar[i] = 0u; }
  XcdBarrier xbs; xbs.bar = xbar; xbs.x = 0u; xbs.st = xst;
#define GBAR { IDS; xcd_barrier(xbs, tid, (unsigned)G); }
  REP(0) { RSYNC if (PH & (1 << 0)) {  { IDS; p0_phase(P, shm, bid, G, tid, wid, lane); } } }
  grid.sync();
  { IDS; xbs = xcd_barrier_post(xbar, xst, tid); }
  REP(1) { RSYNC if (PH & (1 << 1)) {  { IDS; norm_mod_phase(P.x, P.e_norm_g, mod0, (bf16_t*)(ws + O_H), gw, ngw, lane); } } }
  GBAR
  if (DUP & (1 << 14)) { for (int xb = 0; xb < 10; ++xb) GBAR }
  REP(2) if ((PH & (1 << 5)) && (PHG & (1 << 0))) { IDS; pg8::Gemm g{(const bf16_t*)(ws + O_H), (const bf16_t*)(ws + O_WT_IN_E), L, 4608, 2048}; pg8::StaticOrder S; S.init(L, 4608, G, bid);
    pg8::EpiSplit E{ws, 0}; pg8::gemm_phase<pg8::EpiSplit, pg8::StaticOrder, GAL_SPLIT, true>(glds, g, S, E, tid); }
  { IDS; const int rem = 1152 % G, first = rem ? rem : 0;
    if (bid >= first) gemm_tail_fill(P, shm, (bid - first) * 8 + wid, (G - first) * 8, wid, lane); }
  GBAR
  REP(3) { RSYNC if (PH & (1 << 2)) {  { IDS; kprep_gqa_phase(P, gw, ngw, lane); } }
  if (PH & (1 << 3)) {  { IDS; s5_phase<false>(P, shm, gw, ngw, wid, lane); } } }
  GBAR
  { IDS; s5_carry_phase(P, bid, G, wid, lane); }
  GBAR
  REP(4) { RSYNC if (PH & (1 << 4)) {  { IDS; s5_phase<true>(P, shm, gw, ngw, wid, lane); } } }
  GBAR
  REP(5) if (PH & (1 << 6)) for (int u = bid; u < 512; u += G) {
    IDS; const int h = GQA_HMAJOR ? (u >> 6) : (u & 7), qb = GQA_HMAJOR ? (u & 63) : (u >> 3), kvh = h >> 2; const size_t tok0 = (size_t)qb * 256;
    __syncthreads();
    attn_body<0, 1024, 256, 2048, SDG>((const bf16_t*)(ws + O_RA) + tok0 * 1024 + h * 128, (const bf16_t*)(ws + O_KN) + kvh * 128, (const bf16_t*)(ws + O_V0) + kvh * 128,
                                  (const bf16_t*)(ws + O_RA + SZ_LK) + tok0 * 1024 + h * 128, (bf16_t*)(ws + O_OA) + tok0 * 2048 + h * 128, P.e_q_norm, L / 64, (int)tok0, 0, 0, (char*)shm, tid);
  }
  __syncthreads();
  REP(6) if ((PH & (1 << 5)) && (PHG & (1 << 1))) { IDS; pg8::Gemm g{(const bf16_t*)(ws + O_Y), (const bf16_t*)(ws + O_WT_GLU), L, 2048, 1024}; pg8::StaticOrder S; S.init(L, 2048, G, bid);
    pg8::EpiGlu E{ws, P.s5_b_glu}; pg8::gemm_phase<pg8::EpiGlu, pg8::StaticOrder, GAL_GLU, true>(glds, g, S, E, tid); }
  GBAR
  REP(7) if ((PH & (1 << 5)) && (PHG & (1 << 2))) { IDS; pg8::Gemm g{(const bf16_t*)(ws + O_OA), (const bf16_t*)(ws + O_WT_OUT_E), L, 2048, 2048}; pg8::StaticOrder S; S.init(L, 2048, G, bid);
    pg8::EpiResX E{P.x, P.out, mod0 + 4096, (bf16_t*)(ws + O_H), (float*)(ws + O_SSQ1)}; pg8::gemm_phase<pg8::EpiResX, pg8::StaticOrder, GAL_RES, true>(glds, g, S, E, tid); }
  GBAR
  REP(9) if ((PH & (1 << 5)) && (PHG & (1 << 3))) { IDS; pg8::Gemm g{(const bf16_t*)(ws + O_H), (const bf16_t*)(ws + O_WT_IN_O), L, 6912, 2048}; pg8::StaticOrder S; S.init(L, 6912, G, bid);
    pg8::EpiSplit E{ws, 1}; pg8::gemm_phase<pg8::EpiSplit, pg8::StaticOrder, GAL_SPLIT, true>(glds, g, S, E, tid); }
  GBAR
  REP(10) { RSYNC if (PH & (1 << 8)) {  { IDS; prep1_phase(P, shm, gw, ngw, wid, lane, rep_ == 0); } } }
  GBAR
  REP(11) if (PH & (1 << 7)) for (int u = bid; u < 512; u += G) {
    IDS; const int h = u >> 6, rg = u & 63, r0 = rg * 4, t0 = min(max(r0 - 4, 0), 244); const size_t tok0 = (size_t)rg * 256;
    __syncthreads();
    { if (tid < 465) ((float*)(shm + SHM_ATTN))[64 + tid] = P.na_rpb[h * 465 + tid] * (1.f / SCALE); }
    attn_body<1, 1024, 1024, 2048, SDN>((const bf16_t*)(ws + O_RA) + tok0 * 1024 + h * 128, (const bf16_t*)(ws + O_RA + SZ_LK) + (size_t)t0 * 64 * 1024 + h * 128,
                                   (const bf16_t*)(ws + O_RA + 2 * SZ_LK) + (size_t)t0 * 64 * 1024 + h * 128, (const bf16_t*)(ws + O_RA + 3 * SZ_LK) + tok0 * 1024 + h * 128,
                                   (bf16_t*)(ws + O_OA) + tok0 * 2048 + 1024 + h * 128, P.o_q_norm, 12, (int)tok0, r0, t0, (char*)shm, tid);
  }
  REP(12) { RSYNC if (PH & (1 << 10)) {  { IDS; ssd1_phase(P, shm, bid, G, tid, wid, lane); } } }
  GBAR
  if (PH & (1 << 11)) {  { IDS; ssd_carry_phase(P, bid, G, tid); } }
  GBAR
  REP(13) { RSYNC if (PH & (1 << 12)) {  { IDS; ssd2_phase(P, shm, bid, G, tid, wid, lane); } } }
  GBAR
  if ((PH & (1 << 5)) && (PHG & (1 << 4))) { IDS; pg8::Gemm g{(const bf16_t*)(ws + O_OA), (const bf16_t*)(ws + O_WT_OUT_O), L, 2048, 2048}; pg8::StaticOrder S; S.init(L, 2048, G, bid);
    pg8::EpiResScale E{(const float*)(ws + O_H), P.out, mod1 + 4096, (const float*)(ws + O_SSQ)}; pg8::gemm_phase<pg8::EpiResScale, pg8::StaticOrder, GAL_RES, true>(glds, g, S, E, tid); }
}

extern "C" void kernel_launch(void* const* d_in, const int* in_sizes, int n_in, void* d_out, int out_size, void* d_ws, size_t ws_size, hipStream_t stream) {
  static int grid_blocks = 0;
  if (grid_blocks == 0) {
    if (n_in != 33 || out_size != L * DM || ws_size < WS_END) { fprintf(stderr, "kernel_launch: unexpected shapes: n_in %d out %d ws %zu (need %zu)\n", n_in, out_size, ws_size, (size_t)WS_END); grid_blocks = -1; return; }
    int dev = 0, cus = 0, per_cu = 0;
    if (hipGetDevice(&dev) != hipSuccess || hipDeviceGetAttribute(&cus, hipDeviceAttributeMultiprocessorCount, dev) != hipSuccess) { grid_blocks = -1; return; }
    if (hipFuncSetAttribute((const void*)mega_fwd, hipFuncAttributeMaxDynamicSharedMemorySize, LDS_BYTES) != hipSuccess) { fprintf(stderr, "kernel_launch: hipFuncSetAttribute failed\n"); grid_blocks = -1; return; }
    if (hipOccupancyMaxActiveBlocksPerMultiprocessor(&per_cu, (const void*)mega_fwd, 512, LDS_BYTES) != hipSuccess || per_cu < 1) { fprintf(stderr, "kernel_launch: occupancy query says %d\n", per_cu); per_cu = 1; }
    (void)hipGetLastError();
    grid_blocks = cus;
  }
  if (grid_blocks < 0) return;
  Params p{};
  const float** pf = (const float**)&p;
  for (int i = 0; i < 33; ++i) pf[i] = (const float*)d_in[i];
  p.out = (float*)d_out; p.ws = (unsigned char*)d_ws;
  void* args[] = {&p};
  hipError_t e = hipLaunchCooperativeKernel((const void*)mega_fwd, dim3(grid_blocks), dim3(512), args, LDS_BYTES, stream);
  if (e != hipSuccess) fprintf(stderr, "cooperative launch failed: %s (grid %d)\n", hipGetErrorString(e), grid_blocks);
}
```
